# Optimizing an MI355X kernel written in HIP

```python
import math
import jax, jax.numpy as jnp
from jax import lax
import numpy as np

D_MODEL = 2048
BATCH = 4
SEQ = 2048
DEPTH = 2

CHUNK = 64
Q_BLOCK = 128
EPS = 1e-6
NEG_INF = -1e30
MAX_STREAM_OFFSET = 4096

MLA_HEADS = 4
MLA_Q_RANK = 512
MLA_KV_RANK = 256
MLA_NOPE = 128
MLA_ROPE = 64
MLA_V = 128
ROPE_BASE = 10000.0

GLA_HEADS = 4
GLA_DK = 128
GLA_DV = 256
GLA_GATE_RANK = 16
GLA_TAU = 16.0

DSA_HEADS = 4
DSA_DH = 128
IDX_HEADS = 8
IDX_DIM = 64
DSA_TOPK_MAX = 256

MLA_WIDTH = MLA_HEADS * MLA_V
GLA_WIDTH = GLA_HEADS * GLA_DV
DSA_WIDTH = DSA_HEADS * DSA_DH
D_MIX = MLA_WIDTH + GLA_WIDTH + DSA_WIDTH

SPLIT_SIZES = (
    MLA_Q_RANK, MLA_KV_RANK, MLA_ROPE,
    GLA_HEADS * GLA_DK, GLA_HEADS * GLA_DK, GLA_WIDTH,
    GLA_GATE_RANK, GLA_WIDTH,
    DSA_HEADS * DSA_DH, DSA_DH, DSA_DH,
    IDX_HEADS * IDX_DIM, IDX_DIM, IDX_HEADS,
)
D_PROJ = sum(SPLIT_SIZES)

D_FF = 5632
N_EXPERTS = 8
TOP_K = 2
D_FF_EXPERT = 2816
N_DENSE = (DEPTH + 1) // 2
N_MOE = DEPTH // 2

kernel_name = "hybrid_mla_gla_dsa_adaln_moe_encoder"


def rmsnorm(x, g):
    x32 = x.astype(jnp.float32)
    y = x32 * lax.rsqrt(jnp.mean(x32 * x32, axis=-1, keepdims=True) + EPS)
    return y.astype(x.dtype) * g


def rope(x, pos):
    half = x.shape[-1] // 2
    inv = ROPE_BASE ** (-jnp.arange(half, dtype=jnp.float32) / half)
    ang = pos.astype(jnp.float32)[..., None] * inv
    cos = jnp.cos(ang)[:, :, None, :].astype(x.dtype)
    sin = jnp.sin(ang)[:, :, None, :].astype(x.dtype)
    x1, x2 = x[..., :half], x[..., half:]
    return jnp.concatenate([x1 * cos - x2 * sin, x1 * sin + x2 * cos], axis=-1)


def alibi_slopes(n):
    return jnp.asarray([2.0 ** (-8.0 * (h + 1) / n) for h in range(n)], dtype=jnp.float32)


def to_blocks(a, nb):
    return jnp.moveaxis(a.reshape((a.shape[0], nb, Q_BLOCK) + a.shape[2:]), 1, 0)


def from_blocks(a):
    a = jnp.moveaxis(a, 0, 1)
    return a.reshape((a.shape[0], a.shape[1] * a.shape[2]) + a.shape[3:])


def gather_rows(src, idx):
    return jax.vmap(lambda s_, i_: s_[i_])(src, idx)


def mla_mixer(c_q, c_kv, k_rope, q_norm_g, kv_norm_g, w_uq, w_ukv, positions):
    B, S, _ = c_q.shape
    nb = S // Q_BLOCK
    q = (rmsnorm(c_q, q_norm_g) @ w_uq).reshape(B, S, MLA_HEADS, MLA_NOPE + MLA_ROPE)
    kv = (rmsnorm(c_kv, kv_norm_g) @ w_ukv).reshape(B, S, MLA_HEADS, MLA_NOPE + MLA_V)
    q_nope, q_pe = q[..., :MLA_NOPE], rope(q[..., MLA_NOPE:], positions)
    k_nope, v = kv[..., :MLA_NOPE], kv[..., MLA_NOPE:]
    k_pe = rope(k_rope[:, :, None, :], positions)[:, :, 0]
    scale = (MLA_NOPE + MLA_ROPE) ** -0.5
    key_chunk = jnp.arange(S) // CHUNK
    q_chunk = (jnp.arange(S) // CHUNK).reshape(nb, Q_BLOCK)

    def attend(args):
        qn, qp, qc = args
        s = (jnp.einsum('bqhd,bkhd->bhqk', qn, k_nope)
             + jnp.einsum('bqhr,bkr->bhqk', qp, k_pe)).astype(jnp.float32) * scale
        mask = key_chunk[None, :] <= qc[:, None]
        s = jnp.where(mask[None, None], s, NEG_INF)
        p = jax.nn.softmax(s, axis=-1).astype(v.dtype)
        return jnp.einsum('bhqk,bkhd->bqhd', p, v)

    out = lax.map(attend, (to_blocks(q_nope, nb), to_blocks(q_pe, nb), q_chunk))
    return from_blocks(out).reshape(B, S, MLA_WIDTH)


def gla_mixer(q, k, v, g_low, r, w_gate, b_gate, norm_g):
    B, S, _ = q.shape
    nc = S // CHUNK
    q = q.reshape(B, nc, CHUNK, GLA_HEADS, GLA_DK) * (GLA_DK ** -0.5)
    k = k.reshape(B, nc, CHUNK, GLA_HEADS, GLA_DK)
    v = v.reshape(B, nc, CHUNK, GLA_HEADS, GLA_DV)
    log_a = jax.nn.log_sigmoid((g_low @ w_gate + b_gate).astype(jnp.float32)) / GLA_TAU
    log_a = log_a.reshape(B, nc, CHUNK, GLA_HEADS, GLA_DK)
    cum = jnp.cumsum(log_a, axis=2)
    total = cum[:, :, -1]
    k_dec = k * jnp.exp(total[:, :, None] - cum).astype(k.dtype)
    chunk_kv = jnp.einsum('bnchk,bnchv->nbhkv', k_dec, v).astype(jnp.float32)
    chunk_decay = jnp.moveaxis(jnp.exp(total), 1, 0)

    def step(state, inp):
        decay, kv_c = inp
        state = state * decay[..., None] + kv_c
        return state, state

    init = jnp.zeros((B, GLA_HEADS, GLA_DK, GLA_DV), jnp.float32)
    _, states = lax.scan(step, init, (chunk_decay, chunk_kv))
    o = jnp.einsum('bnchk,nbhkv->bnchv', q, states.astype(q.dtype))
    o = rmsnorm(o, norm_g).reshape(B, S, GLA_WIDTH)
    return o * jax.nn.silu(r)


def dsa_mixer(q, k, v, iq, ik, iw, positions):
    B, S, _ = q.shape
    nb = S // Q_BLOCK
    topk = min(DSA_TOPK_MAX, S // 4)
    q = q.reshape(B, S, DSA_HEADS, DSA_DH)
    iq = iq.reshape(B, S, IDX_HEADS, IDX_DIM)
    slopes = alibi_slopes(DSA_HEADS)
    key_chunk = jnp.arange(S) // CHUNK
    q_chunk = (jnp.arange(S) // CHUNK).reshape(nb, Q_BLOCK)
    scale = DSA_DH ** -0.5

    def attend(args):
        qb, iqb, iwb, pb, qc = args
        dots = jnp.einsum('bqhd,bsd->bqhs', iqb, ik).astype(jnp.float32)
        score = jnp.einsum('bqh,bqhs->bqs', iwb.astype(jnp.float32), jax.nn.relu(dots))
        admissible = key_chunk[None, None, :] <= qc[None, :, None]
        score = jnp.where(admissible, score, NEG_INF)
        _, top_idx = lax.top_k(score, topk)
        valid = key_chunk[top_idx] <= qc[None, :, None]
        k_sel = gather_rows(k, top_idx)
        v_sel = gather_rows(v, top_idx)
        p_sel = gather_rows(positions, top_idx)
        s = jnp.einsum('bqhd,bqkd->bhqk', qb, k_sel).astype(jnp.float32) * scale
        dist = jnp.abs(pb[:, :, None] - p_sel).astype(jnp.float32)
        s = s - slopes[None, :, None, None] * dist[:, None]
        s = jnp.where(valid[:, None], s, NEG_INF)
        p = jax.nn.softmax(s, axis=-1).astype(v_sel.dtype)
        return jnp.einsum('bhqk,bqkd->bqhd', p, v_sel)

    out = lax.map(attend, (to_blocks(q, nb), to_blocks(iq, nb), to_blocks(iw, nb),
                           to_blocks(positions, nb), q_chunk))
    return from_blocks(out).reshape(B, S, DSA_WIDTH)


def swiglu(h, w_gate, w_up, w_down):
    return (jax.nn.silu(h @ w_gate) * (h @ w_up)) @ w_down


def moe_ffn(h, router_w, router_b, w_gate, w_up, w_down):
    B, S, D = h.shape
    t = h.reshape(B * S, D)
    logits = (t @ router_w).astype(jnp.float32) + router_b.astype(jnp.float32)
    top_val, top_idx = lax.top_k(logits, TOP_K)
    top_w = jax.nn.softmax(top_val, axis=-1)
    combine = jnp.sum(jax.nn.one_hot(top_idx, N_EXPERTS, dtype=jnp.float32) * top_w[..., None], axis=1)
    combine = combine.astype(t.dtype)
    out = jnp.zeros_like(t)
    for e in range(N_EXPERTS):
        out = out + combine[:, e:e + 1] * swiglu(t, w_gate[e], w_up[e], w_down[e])
    return out.reshape(B, S, D)


def setup_inputs(seed: int = 0) -> dict:
    key = jax.random.key(seed)
    ks = jax.random.split(key, 32)
    f32 = jnp.float32

    def nrm(k, shape, scale):
        return jax.random.normal(k, shape, f32) * scale

    D = D_MODEL
    offsets = jax.random.randint(ks[2], (BATCH, 1), 0, MAX_STREAM_OFFSET, dtype=jnp.int32)
    positions = offsets + jnp.arange(SEQ, dtype=jnp.int32)[None, :]
    return {
        "x": nrm(ks[0], (BATCH, SEQ, D), 1.0),
        "c": nrm(ks[1], (BATCH, D), 1.0),
        "positions": positions,
        "ada_w": nrm(ks[3], (DEPTH, D, 6 * D), 0.5 * D ** -0.5),
        "ada_b": nrm(ks[4], (DEPTH, 6 * D), 0.01),
        "norm1_g": 1.0 + nrm(ks[5], (DEPTH, D), 0.02),
        "norm2_g": 1.0 + nrm(ks[6], (DEPTH, D), 0.02),
        "w_in": nrm(ks[7], (DEPTH, D, D_PROJ), D ** -0.5),
        "mla_q_norm_g": 1.0 + nrm(ks[8], (DEPTH, MLA_Q_RANK), 0.02),
        "mla_kv_norm_g": 1.0 + nrm(ks[9], (DEPTH, MLA_KV_RANK), 0.02),
        "mla_w_uq": nrm(ks[10], (DEPTH, MLA_Q_RANK, MLA_HEADS * (MLA_NOPE + MLA_ROPE)), MLA_Q_RANK ** -0.5),
        "mla_w_ukv": nrm(ks[11], (DEPTH, MLA_KV_RANK, MLA_HEADS * (MLA_NOPE + MLA_V)), MLA_KV_RANK ** -0.5),
        "gla_w_gate": nrm(ks[12], (DEPTH, GLA_GATE_RANK, GLA_HEADS * GLA_DK), GLA_GATE_RANK ** -0.5),
        "gla_b_gate": nrm(ks[13], (DEPTH, GLA_HEADS * GLA_DK), 0.1),
        "gla_norm_g": 1.0 + nrm(ks[14], (DEPTH, GLA_DV), 0.02),
        "w_out": nrm(ks[15], (DEPTH, D_MIX, D), D_MIX ** -0.5),
        "ffn_w_gate": nrm(ks[16], (N_DENSE, D, D_FF), D ** -0.5),
        "ffn_w_up": nrm(ks[17], (N_DENSE, D, D_FF), D ** -0.5),
        "ffn_w_down": nrm(ks[18], (N_DENSE, D_FF, D), D_FF ** -0.5),
        "moe_router_w": nrm(ks[19], (N_MOE, D, N_EXPERTS), D ** -0.5),
        "moe_router_b": nrm(ks[20], (N_MOE, N_EXPERTS), 0.01),
        "moe_w_gate": nrm(ks[21], (N_MOE, N_EXPERTS, D, D_FF_EXPERT), D ** -0.5),
        "moe_w_up": nrm(ks[22], (N_MOE, N_EXPERTS, D, D_FF_EXPERT), D ** -0.5),
        "moe_w_down": nrm(ks[23], (N_MOE, N_EXPERTS, D_FF_EXPERT, D), D_FF_EXPERT ** -0.5),
        "final_norm_g": 1.0 + nrm(ks[24], (D,), 0.02),
    }


def reference(x, c, positions, ada_w, ada_b, norm1_g, norm2_g, w_in, mla_q_norm_g, mla_kv_norm_g,
              mla_w_uq, mla_w_ukv, gla_w_gate, gla_b_gate, gla_norm_g, w_out, ffn_w_gate, ffn_w_up,
              ffn_w_down, moe_router_w, moe_router_b, moe_w_gate, moe_w_up, moe_w_down, final_norm_g):
    split_points = [int(p) for p in np.cumsum(SPLIT_SIZES)[:-1]]
    c_act = jax.nn.silu(c)
    for l in range(DEPTH):
        mod = c_act @ ada_w[l] + ada_b[l]
        sh1, sc1, g1, sh2, sc2, g2 = jnp.split(mod, 6, axis=-1)
        h = rmsnorm(x, norm1_g[l]) * (1.0 + sc1[:, None, :]) + sh1[:, None, :]
        proj = h @ w_in[l]
        (c_q, c_kv, k_pe, gq, gk, gv, g_low, g_r,
         dq, dk, dv, iq, ik, iw) = jnp.split(proj, split_points, axis=-1)
        o_mla = mla_mixer(c_q, c_kv, k_pe, mla_q_norm_g[l], mla_kv_norm_g[l],
                          mla_w_uq[l], mla_w_ukv[l], positions)
        o_gla = gla_mixer(gq, gk, gv, g_low, g_r, gla_w_gate[l], gla_b_gate[l], gla_norm_g[l])
        o_dsa = dsa_mixer(dq, dk, dv, iq, ik, iw, positions)
        mix = jnp.concatenate([o_mla, o_gla, o_dsa], axis=-1) @ w_out[l]
        x = x + g1[:, None, :] * mix
        h = rmsnorm(x, norm2_g[l]) * (1.0 + sc2[:, None, :]) + sh2[:, None, :]
        j = l // 2
        if l % 2 == 0:
            f = swiglu(h, ffn_w_gate[j], ffn_w_up[j], ffn_w_down[j])
        else:
            f = moe_ffn(h, moe_router_w[j], moe_router_b[j], moe_w_gate[j], moe_w_up[j], moe_w_down[j])
        x = x + g2[:, None, :] * f
    return rmsnorm(x, final_norm_g)
```

```cpp
#include <hip/hip_runtime.h>
#include <cstdio>
#include <cstdint>

#ifndef MK_LAUNCH_PER_PHASE
#define MK_LAUNCH_PER_PHASE 0
#endif

#ifndef JREP_MASK
#define JREP_MASK 0x0u
#endif
#define JREP(j) _Pragma("unroll") for (int jrep_ = 0; jrep_ < 1 + (int)(((JREP_MASK) >> (j)) & 1u); ++jrep_)
#define JEXTRA(j) if ((((JREP_MASK) >> (j)) & 1u) != 0u)
#define LAS __attribute__((address_space(3)))
typedef unsigned short us;
typedef unsigned long long u64;
typedef short bf16x8 __attribute__((ext_vector_type(8)));
typedef short bf16x4 __attribute__((ext_vector_type(4)));
typedef float f32x4 __attribute__((ext_vector_type(4)));
typedef float f32x2 __attribute__((ext_vector_type(2)));
typedef unsigned u32x4 __attribute__((ext_vector_type(4)));
typedef unsigned u32x2 __attribute__((ext_vector_type(2)));
typedef int i32x4 __attribute__((ext_vector_type(4)));
typedef int i32x8 __attribute__((ext_vector_type(8)));

constexpr int D = 2048, NB = 4, SEQ = 2048, NTOK = 8192;
constexpr int DPROJ = 5272, DPROJ_P = 5376;
constexpr int NP8 = 4608;
constexpr int C_GQ = 0, C_GK = 512, C_GV = 1024, C_GR = 2048, C_CQ = 3072, C_CKV = 3584, C_KPE = 3840, C_GLOW = 3904,
              C_DQ = 3920, C_DK = 4432, C_DV = 4560, C_IQ = 4688, C_IK = 5200, C_IW = 5264;
constexpr int DFF = 5632, DFFE = 2816, NEXP = 8;
constexpr int MOE_ROWS = 18432;
constexpr float EPS = 1e-6f;

constexpr size_t al256(size_t x) { return (x + 255) & ~(size_t)255; }
constexpr size_t WS_BAR = 0;
constexpr size_t WS_NCNT = 16384;
constexpr size_t WS_MOECTL = 32768;
constexpr size_t WS_MOD = WS_MOECTL + 1024;
constexpr size_t WS_CS = al256(WS_MOD + (size_t)2 * 4 * 12288 * 4);
constexpr size_t WS_RSTD = al256(WS_CS + (size_t)NTOK * 32 * 8);
constexpr size_t WS_ROUTE = al256(WS_RSTD + (size_t)2 * NTOK * 4);
constexpr size_t WS_WIN = al256(WS_ROUTE + (size_t)6 * NTOK * 4);
constexpr size_t WS_WUQ = al256(WS_WIN + (size_t)2 * DPROJ_P * D * 2);
constexpr size_t WS_WUKV = al256(WS_WUQ + (size_t)2 * 768 * 512 * 2);
constexpr size_t WS_WOUT = al256(WS_WUKV + (size_t)2 * 1024 * 256 * 2);
constexpr size_t WS_WGU = al256(WS_WOUT + (size_t)2 * D * D * 2);
constexpr size_t WS_WD = al256(WS_WGU + (size_t)2 * DFF * D * 2);
constexpr size_t WS_MGU = al256(WS_WD + (size_t)D * DFF * 2);
constexpr size_t WS_MD = al256(WS_MGU + (size_t)NEXP * 2 * DFFE * D * 2);
constexpr size_t WS_H = al256(WS_MD + (size_t)NEXP * D * DFFE * 2);
constexpr size_t WS_PROJ = al256(WS_H + (size_t)NTOK * D * 2);
constexpr size_t WS_Q = al256(WS_PROJ + (size_t)NTOK * DPROJ_P * 2);
constexpr size_t WS_KN = al256(WS_Q + (size_t)NTOK * 768 * 2);
constexpr size_t WS_VT = al256(WS_KN + (size_t)NTOK * 512 * 2);
constexpr size_t WS_KPE = al256(WS_VT + (size_t)512 * NTOK * 2);
constexpr size_t WS_DVT = al256(WS_KPE + (size_t)NTOK * 64 * 2);
constexpr size_t WS_MASK = al256(WS_DVT + (size_t)4 * 128 * 2048 * 2);
constexpr size_t WS_CKV = al256(WS_MASK + (size_t)NTOK * 32 * 8);
constexpr size_t WS_ST = al256(WS_CKV + (size_t)4 * 32 * 4 * 256 * 128 * 4);
constexpr size_t WS_DEC = al256(WS_ST + (size_t)4 * 32 * 4 * 256 * 128 * 2);
constexpr size_t WS_MIX = al256(WS_DEC + (size_t)4 * 32 * 4 * 128 * 4);
constexpr size_t WS_ACT = al256(WS_MIX + (size_t)NTOK * D * 2);
constexpr size_t WS_XG = al256(WS_ACT + (size_t)MOE_ROWS * DFFE * 2);
constexpr size_t WS_Y = al256(WS_XG + (size_t)MOE_ROWS * D * 2);
constexpr size_t WS_XB = al256(WS_Y + (size_t)MOE_ROWS * D * 2);
constexpr size_t WS_H8 = al256(WS_XB + (size_t)NTOK * D * 2);
constexpr size_t WS_WIN8 = al256(WS_H8 + (size_t)NTOK * D);
constexpr size_t WS_NSLOT = al256(WS_WIN8 + (size_t)2 * NP8 * D);
constexpr size_t WS_END = al256(WS_NSLOT + (size_t)2 * NTOK * 8 * 4);
static_assert((size_t)NTOK * DFF * 2 <= (size_t)MOE_ROWS * DFFE * 2, "act buffer");

constexpr int LDS_WORK = 131584;
constexpr int LDS_CTL = LDS_WORK;
constexpr int LDS_BYTES = LDS_WORK + 256;

__device__ __forceinline__ float bf2f(us b) { return __uint_as_float(((unsigned)b) << 16); }
__device__ __forceinline__ us f2bf(float f) { unsigned u = __float_as_uint(f); u += 0x7FFFu + ((u >> 16) & 1u); return (us)(u >> 16); }
__device__ __forceinline__ unsigned pk2(float lo, float hi) { return (unsigned)f2bf(lo) | ((unsigned)f2bf(hi) << 16); }
__device__ __forceinline__ unsigned pk4_fp8(float a, float b, float c, float d) { int w = 0; w = __builtin_amdgcn_cvt_pk_fp8_f32(a, b, w, false); w = __builtin_amdgcn_cvt_pk_fp8_f32(c, d, w, true); return (unsigned)w; }
#define DPP_ADD_F(v, ctrl, rmask) v += __builtin_bit_cast(float, __builtin_amdgcn_update_dpp(0, __builtin_bit_cast(int, v), ctrl, rmask, 0xf, false))
__device__ __forceinline__ float wave_sum(float v) {
    DPP_ADD_F(v, 0xB1, 0xf); DPP_ADD_F(v, 0x4E, 0xf); DPP_ADD_F(v, 0x141, 0xf); DPP_ADD_F(v, 0x140, 0xf); DPP_ADD_F(v, 0x142, 0xa); DPP_ADD_F(v, 0x143, 0xc);
    return __builtin_bit_cast(float, __builtin_amdgcn_readlane(__builtin_bit_cast(int, v), 63));
}
__device__ __forceinline__ int wave_sum_i(int v) {
#pragma unroll
    for (int o = 32; o > 0; o >>= 1) v += __shfl_xor(v, o);
    return v;
}
__device__ __forceinline__ float rows_max(float v) {
    { const auto r = __builtin_amdgcn_permlane16_swap(__float_as_uint(v), __float_as_uint(v), false, false); v = fmaxf(__uint_as_float(r[0]), __uint_as_float(r[1])); }
    { const auto r = __builtin_amdgcn_permlane32_swap(__float_as_uint(v), __float_as_uint(v), false, false); v = fmaxf(__uint_as_float(r[0]), __uint_as_float(r[1])); }
    return v;
}
__device__ __forceinline__ float rows_sum(float v) {
    { const auto r = __builtin_amdgcn_permlane16_swap(__float_as_uint(v), __float_as_uint(v), false, false); v = __uint_as_float(r[0]) + __uint_as_float(r[1]); }
    { const auto r = __builtin_amdgcn_permlane32_swap(__float_as_uint(v), __float_as_uint(v), false, false); v = __uint_as_float(r[0]) + __uint_as_float(r[1]); }
    return v;
}
__device__ __forceinline__ float siluf(float x) { return x * __builtin_amdgcn_rcpf(1.0f + __expf(-x)); }
__device__ __forceinline__ f32x4 mfma16(bf16x8 a, bf16x8 b, f32x4 c) { return __builtin_amdgcn_mfma_f32_16x16x32_bf16(a, b, c, 0, 0, 0); }
__device__ __forceinline__ bf16x8 ld8(const us* p) { return *(const bf16x8*)p; }

#define XB_TMO      128
#define XB_XCNT(j)  (256  + 64 * (j))
#define XB_XSUB(j)  (1280 + 64 * (j))
#define XB_XGEN(j)  (2304 + 64 * (j))
#define XB_TOP      3328
#define XB_TOPGEN   3392
#define XCD_BAR_WORDS 3456
#define XB_SPIN_CAP (1u << 22)

__device__ __forceinline__ unsigned xb_ld(unsigned* p)              { return __hip_atomic_load(p, __ATOMIC_RELAXED, __HIP_MEMORY_SCOPE_AGENT); }
__device__ __forceinline__ unsigned xb_add(unsigned* p, unsigned v) { return __hip_atomic_fetch_add(p, v, __ATOMIC_RELAXED, __HIP_MEMORY_SCOPE_AGENT); }
__device__ __forceinline__ unsigned xb_xcc_id() { return (unsigned)__builtin_amdgcn_s_getreg((3 << 11) | 20) & 0xFu; }
#define XB_SPIN(cond, bar) do { unsigned _sp = 0; while (cond) { __builtin_amdgcn_s_sleep(1); \
    if ((++_sp & 255u) == 0u) { if (xb_ld(&(bar)[XB_TMO])) break; if (_sp > XB_SPIN_CAP) { atomicAdd(&(bar)[XB_TMO], 1u); break; } } } } while (0)

struct XcdBarrier { unsigned* bar; unsigned x; volatile LAS unsigned* st; };

__device__ __forceinline__ XcdBarrier xcd_barrier_post(unsigned* bar, volatile LAS unsigned* st) {
    XcdBarrier b; b.bar = bar; b.x = xb_xcc_id(); b.st = st;
    if (threadIdx.x == 0) (void)xb_add(&bar[XB_XCNT(b.x)], 1u);
    return b;
}
__device__ __forceinline__ void xcd_barrier_complete(unsigned* bar, unsigned x, unsigned& nloc, unsigned& nx) {
    const unsigned G = gridDim.x * gridDim.y * gridDim.z;
    unsigned sum, cnt, mine, sp = 0u;
    for (;;) {
        sum = 0u; cnt = 0u; mine = 0u;
#pragma unroll
        for (unsigned j = 0; j < 16; ++j) { const unsigned c = xb_ld(&bar[XB_XCNT(j)]); sum += c; cnt += (c > 0u) ? 1u : 0u; mine = (j == x) ? c : mine; }
        if (sum == G) break;
        __builtin_amdgcn_s_sleep(1);
        if ((++sp & 255u) == 0u) { if (xb_ld(&bar[XB_TMO])) break; if (sp > XB_SPIN_CAP) { atomicAdd(&bar[XB_TMO], 1u); break; } }
    }
    nloc = mine > 0u ? mine : 1u; nx = cnt > 0u ? cnt : 1u;
}
__device__ __forceinline__ void xcd_barrier(const XcdBarrier& b) {
    asm volatile("s_waitcnt vmcnt(0)" ::: "memory");
    __syncthreads();
    if (threadIdx.x == 0) {
        unsigned* bar = b.bar;
        __builtin_amdgcn_s_waitcnt(0);
        unsigned nloc = b.st[0], nx = b.st[1];
        if (nloc == 0u) { xcd_barrier_complete(bar, b.x, nloc, nx); b.st[0] = nloc; b.st[1] = nx; }
        const unsigned old = xb_add(&bar[XB_XSUB(b.x)], 1u);
        const unsigned gen = old / nloc;
        if (old + 1u == (gen + 1u) * nloc) {
            __builtin_amdgcn_fence(__ATOMIC_RELEASE, "agent");
            asm volatile("s_waitcnt vmcnt(0)" ::: "memory");
            const unsigned og = xb_add(&bar[XB_TOP], 1u);
            const unsigned tg = og / nx;
            if (og + 1u == (tg + 1u) * nx) xb_add(&bar[XB_TOPGEN], 1u);
            else XB_SPIN(xb_ld(&bar[XB_TOPGEN]) == tg, bar);
            xb_add(&bar[XB_XGEN(b.x)], 1u);
            __builtin_amdgcn_fence(__ATOMIC_ACQUIRE, "agent");
            asm volatile("s_waitcnt vmcnt(0)" ::: "memory");
        } else {
            XB_SPIN(xb_ld(&bar[XB_XGEN(b.x)]) == gen, bar);
            __builtin_amdgcn_fence(__ATOMIC_ACQUIRE, "agent");
            asm volatile("s_waitcnt vmcnt(0)" ::: "memory");
        }
    }
    __syncthreads();
}

namespace pg8 {
constexpr int BM = 256, BK = 64, HALF = 128, HTB = HALF * BK * 2, STAGE_BYTES = 8 * HTB, NXCD = 8, WGM = 8;
__host__ __device__ __forceinline__ int lds_byte(int r, int c) { const int st = (r >> 4) * 2 + (c >> 5), rr = r & 15, cc = c & 31, ob = rr * 64 + cc * 2; return st * 1024 + (ob ^ (((ob >> 9) & 1) << 5)); }
__host__ __device__ __forceinline__ void stage_rc(int b, int& R, int& C) { const int st = b / 1024, sb = b % 1024, swz = sb ^ (((sb >> 9) & 1) << 5); R = (st >> 1) * 16 + swz / 64; C = (st & 1) * 32 + (swz % 64) / 2; }
__host__ __device__ __forceinline__ int perm32(int rho) { const int n = rho >> 4, i = rho & 15; return 8 * (i >> 2) + 4 * n + (i & 3); }

struct Unit { int pm, pn; const char* a; const char* b; };
struct Gemm { int lda, ldb, K; };

__device__ __forceinline__ void remap(int L, int nwg, int nM, int nN, int& pm, int& pn) {
    int wgid = L; { const int q = nwg / NXCD, r = nwg % NXCD, xcd = wgid % NXCD, off = wgid / NXCD; wgid = (xcd < r ? xcd * (q + 1) : r * (q + 1) + (xcd - r) * q) + off; }
    const int nig = WGM * nN, gid = wgid / nig, fm = gid * WGM, gsz = (nM - fm) < WGM ? (nM - fm) : WGM;
    pm = fm + ((wgid % nig) % gsz); pn = (wgid % nig) / gsz;
}
struct DenseSched {
    const char* A; const char* B; size_t tA, tB; int nM, nN, nwg, G, c, base, lim;
    __device__ __forceinline__ void init(const void* A_, const void* B_, int lda, int ldb, int M, int N, int G_, int c_, int base_ = 0, int lim_ = 0x7fffffff) { A = (const char*)A_; B = (const char*)B_; tA = (size_t)BM * lda * 2; tB = (size_t)BM * ldb * 2; nM = M / BM; nN = N / BM; nwg = nM * nN; G = G_; c = c_; base = base_; lim = lim_ < nwg ? lim_ : nwg; }
    __device__ __forceinline__ bool next(int i, Unit& u) const {
        const long L = (long)base + (long)i * G + c; if (c < 0 || L >= lim) return false;
        remap((int)L, nwg, nM, nN, u.pm, u.pn); u.a = A + (size_t)u.pm * tA; u.b = B + (size_t)u.pn * tB; return true;
    }
};
__device__ __forceinline__ void remap_moe(int L, int nwg, int nM, int nN, int wgm, int rot, int& pm, int& pn) {
    const int q = nwg / NXCD, r = nwg % NXCD, xcd = L % NXCD; int off = L / NXCD;
    const int len = q + (xcd < r ? 1 : 0), start = xcd < r ? xcd * (q + 1) : r * (q + 1) + (xcd - r) * q;
    if (rot > 0) { const int re = rot + (nN - (start + rot) % nN) % nN; if (re < len) { off += re; if (off >= len) off -= len; } }
    const int wgid = start + off, nig = wgm * nN, gid = wgid / nig, fm = gid * wgm, gsz = (nM - fm) < wgm ? (nM - fm) : wgm;
    pm = fm + ((wgid % nig) % gsz); pn = (wgid % nig) / gsz;
}
__device__ __forceinline__ unsigned* moe_cnt(unsigned* base, int t) { return base + 16 + (t & 63) * 64 + (t >> 6) * 16; }
struct MoeSched {
    const char* A; const char* B; size_t tA, tB, eB; const int* tile_e; const int* s2t; int nM, nN, nwg, G, c, wgm, rot, i0, lim;
    __device__ __forceinline__ void init(const void* A_, const void* B_, int lda, int ldb, size_t eB_, const int* ctl, int N, int G_, int c_, int wgm_, int rot_, int i0_ = 0, int lim_ = 0x7fffffff) {
        A = (const char*)A_; B = (const char*)B_; tA = (size_t)BM * lda * 2; tB = (size_t)BM * ldb * 2; eB = eB_;
        nM = ctl[0]; tile_e = ctl + 16; nN = N / BM; nwg = nM * nN; G = G_; c = c_; wgm = wgm_; rot = rot_; i0 = i0_; lim = lim_ < nwg ? lim_ : nwg; s2t = nullptr; }
    __device__ __forceinline__ bool next(int i, Unit& u) const {
        const long L = (long)(i + i0) * G + c; if (L >= lim) return false;
        remap_moe((int)L, nwg, nM, nN, wgm, rot, u.pm, u.pn); u.a = s2t != nullptr ? A : A + (size_t)u.pm * tA; u.b = B + (size_t)tile_e[u.pm] * eB + (size_t)u.pn * tB; return true;
    }
};
__device__ __forceinline__ void cnt_wait(unsigned* p, unsigned need, unsigned* tmo) {
    if (__builtin_amdgcn_readfirstlane((int)threadIdx.x >> 6) == 0) { unsigned sp = 0;
        while ((unsigned)__builtin_amdgcn_readfirstlane(__hip_atomic_load(p, __ATOMIC_RELAXED, __HIP_MEMORY_SCOPE_AGENT)) < need) {
            __builtin_amdgcn_s_sleep(1);
            if ((++sp & 255u) == 0u) { if (__hip_atomic_load(tmo, __ATOMIC_RELAXED, __HIP_MEMORY_SCOPE_AGENT)) break; if (sp > XB_SPIN_CAP) { if ((threadIdx.x & 63) == 0) atomicAdd(tmo, 1u); break; } } }
        __builtin_amdgcn_fence(__ATOMIC_ACQUIRE, "agent");
        asm volatile("s_waitcnt vmcnt(0)" ::: "memory"); }
}
__device__ __forceinline__ void moe_wait(unsigned* cnt, int pm, unsigned need, unsigned* tmo) { cnt_wait(moe_cnt(cnt, pm), need, tmo); }

template <class Epi, class Sched, bool ALIGN_EPI = false, bool SP2 = true, bool FP8 = false, bool GA = false>
__device__ __forceinline__ void gemm_phase(LAS unsigned char* lds, const Gemm g, const Sched& S, const Epi& E) {
    const int tid = threadIdx.x, wid = __builtin_amdgcn_readfirstlane(tid >> 6), lane = tid & 63, wr = wid >> 2, wc = wid & 3, fr = lane & 15, fq = lane >> 4;
    int Kq = g.K; asm volatile("" : "+s"(Kq));
    const int K = Kq, nt = K / BK;
    static_assert(!GA || SP2, "gathered A rows: SP2 schedule only");
    unsigned voffA[2], voffB[2], voffA1[2] = {0u, 0u}, nvA[2] = {0u, 0u}, nvA1[2] = {0u, 0u};
#pragma unroll
    for (int i = 0; i < 2; ++i) { int R, C; stage_rc(tid * 16 + i * 8192, R, C); const int Rb = Epi::PERM ? ((R & ~31) + perm32(R & 31)) : R;
        voffA[i] = (unsigned)(R * g.lda + C) * 2u; voffB[i] = (unsigned)(Rb * g.ldb + C) * 2u; }
#define PG8_GA_LOAD(pm_, o0, o1) do { _Pragma("unroll") for (int _i = 0; _i < 2; ++_i) { int R_, C_; stage_rc(tid * 16 + _i * 8192, R_, C_); \
        const int t0_ = S.s2t[(pm_) * BM + R_], t1_ = S.s2t[(pm_) * BM + HALF + R_]; o0[_i] = (unsigned)(t0_ * g.lda + C_) * 2u; o1[_i] = (unsigned)(t1_ * g.lda + C_) * 2u; } \
        asm volatile("" : "+v"(o0[0]), "+v"(o0[1]), "+v"(o1[0]), "+v"(o1[1])); } while (0)
    const size_t kstep = (size_t)(BK * 2);
    const size_t hstepA = (size_t)HALF * g.lda * 2, hstepB = (size_t)HALF * g.ldb * 2;
    const unsigned ldsw = (unsigned)wid * 1024u;
    const int aoff = lds_byte(wr * 64 + fr, fq * 8), boff = lds_byte(wc * 32 + fr, fq * 8);
#define PG8_SA(b, h) (((b) * 2 + (h)) * HTB)
#define PG8_SB(b, h) ((4 + (b) * 2 + (h)) * HTB)
#define PG8_STAGE(bufoff, gbase, voff) do { _Pragma("unroll") for (int _i = 0; _i < 2; ++_i) \
        __builtin_amdgcn_global_load_lds((const unsigned*)((const char*)(gbase) + (voff)[_i]), (LAS unsigned*)(lds + (bufoff) + ldsw + _i * 8192), 16, 0, 0); } while (0)
#define PG8_STA(bufoff, base, h, sel) do { if constexpr (GA) { const unsigned o_[2] = {(sel) ? ((h) ? nvA1[0] : nvA[0]) : ((h) ? voffA1[0] : voffA[0]), (sel) ? ((h) ? nvA1[1] : nvA[1]) : ((h) ? voffA1[1] : voffA[1])}; PG8_STAGE(bufoff, base, o_); } \
        else PG8_STAGE(bufoff, (base) + ((h) ? hstepA : (size_t)0), voffA); } while (0)
#define PG8_LDA(dst, b, h) do { _Pragma("unroll") for (int m = 0; m < 4; ++m) { if constexpr (FP8) { const i32x4 lo_ = *(const LAS i32x4*)(lds + PG8_SA(b, h) + aoff + m * 2048), hi_ = *(const LAS i32x4*)(lds + PG8_SA(b, h) + aoff + m * 2048 + 1024); \
        dst##8[m] = __builtin_shufflevector(lo_, hi_, 0, 1, 2, 3, 4, 5, 6, 7); } else { _Pragma("unroll") for (int k = 0; k < 2; ++k) dst[m][k] = *(const LAS bf16x8*)(lds + PG8_SA(b, h) + aoff + m * 2048 + k * 1024); } } } while (0)
#define PG8_LDB(dst, b, h) do { _Pragma("unroll") for (int n = 0; n < 2; ++n) { if constexpr (FP8) { const i32x4 lo_ = *(const LAS i32x4*)(lds + PG8_SB(b, h) + boff + n * 2048), hi_ = *(const LAS i32x4*)(lds + PG8_SB(b, h) + boff + n * 2048 + 1024); \
        dst##8[n] = __builtin_shufflevector(lo_, hi_, 0, 1, 2, 3, 4, 5, 6, 7); } else { _Pragma("unroll") for (int k = 0; k < 2; ++k) dst[n][k] = *(const LAS bf16x8*)(lds + PG8_SB(b, h) + boff + n * 2048 + k * 1024); } } } while (0)
#define PG8_MMA(ai, bj, At, Bt) do { __builtin_amdgcn_s_setprio(1); _Pragma("unroll") for (int m = 0; m < 4; ++m) _Pragma("unroll") for (int n = 0; n < 2; ++n) { \
        if constexpr (FP8) asm volatile("v_mfma_scale_f32_16x16x128_f8f6f4 %0, %1, %2, %0, %3, %3 op_sel_hi:[0,0,0]" : "+v"(acc[ai][bj][m][n]) : "v"(Bt##8[n]), "v"(At##8[m]), "v"(sc8)); \
        else { _Pragma("unroll") for (int k = 0; k < 2; ++k) acc[ai][bj][m][n] = __builtin_amdgcn_mfma_f32_16x16x32_bf16(Bt[n][k], At[m][k], acc[ai][bj][m][n], 0, 0, 0); } } \
        __builtin_amdgcn_s_setprio(0); } while (0)
#define PG8_WAIT_V(n) asm volatile("s_waitcnt vmcnt(" #n ")" ::: "memory")
#define PG8_WAIT_L(n) asm volatile("s_waitcnt lgkmcnt(" #n ")" ::: "memory")
#define PG8_BAR __builtin_amdgcn_s_barrier()
#define PG8_SCHED __builtin_amdgcn_sched_barrier(0)
    Unit cur, nxt; int ui = 0;
    if (!S.next(0, cur)) return;
    f32x4 acc[2][2][4][2];
#pragma unroll
    for (int a = 0; a < 2; ++a)
#pragma unroll
        for (int b = 0; b < 2; ++b)
#pragma unroll
            for (int m = 0; m < 4; ++m)
#pragma unroll
                for (int n = 0; n < 2; ++n) acc[a][b][m][n] = (f32x4){0.f, 0.f, 0.f, 0.f};
    bf16x8 At[4][2], B0[2][2], B1[2][2];
    i32x8 At8[4], B08[2], B18[2];
    int sc8 = 0; if constexpr (FP8) asm volatile("v_mov_b32 %0, 0x7c7c7c7c\n\ts_nop 4" : "=v"(sc8));
    const char* cA = cur.a; const char* cB = cur.b;
    if constexpr (GA) PG8_GA_LOAD(cur.pm, voffA, voffA1);
    if constexpr (SP2) {
        PG8_STAGE(PG8_SB(0, 0), cB, voffB); PG8_STAGE(PG8_SB(0, 1), cB + hstepB, voffB); PG8_STA(PG8_SA(0, 0), cA, 0, false); PG8_STA(PG8_SA(0, 1), cA, 1, false);
        if (wr == 1) PG8_BAR;
        PG8_WAIT_V(2); PG8_BAR;
        PG8_STAGE(PG8_SB(1, 0), cB + kstep, voffB); PG8_STA(PG8_SA(1, 0), cA + kstep, 0, false); PG8_STAGE(PG8_SB(1, 1), cB + hstepB + kstep, voffB);
        PG8_WAIT_V(6); PG8_BAR;
    } else {
        PG8_STAGE(PG8_SB(0, 0), cB, voffB); PG8_STAGE(PG8_SA(0, 0), cA, voffA); PG8_STAGE(PG8_SB(0, 1), cB + hstepB, voffB); PG8_STAGE(PG8_SA(0, 1), cA + hstepA, voffA);
        if (wr == 1) PG8_BAR;
        PG8_WAIT_V(4); PG8_BAR;
        PG8_STAGE(PG8_SB(1, 0), cB + kstep, voffB); PG8_STAGE(PG8_SA(1, 0), cA + kstep, voffA); PG8_STAGE(PG8_SB(1, 1), cB + hstepB + kstep, voffB);
        PG8_WAIT_V(6); PG8_BAR;
    }
    for (;;) {
        const bool has_next = S.next(ui + 1, nxt);
        const char* nA = has_next ? nxt.a : cA; const char* nB = has_next ? nxt.b : cB;
        if constexpr (GA) { if (has_next) PG8_GA_LOAD(nxt.pm, nvA, nvA1); else { nvA[0] = voffA[0]; nvA[1] = voffA[1]; nvA1[0] = voffA1[0]; nvA1[1] = voffA1[1]; } }
#pragma unroll 1
        for (int t = 0; t < nt; t += 2) {
            const bool last = (t == nt - 2);
            const char* a1 = cA + (size_t)(t + 1) * kstep;
            const char* a2 = last ? nA : cA + (size_t)(t + 2) * kstep; const char* b2 = last ? nB : cB + (size_t)(t + 2) * kstep;
            const char* a3 = a2 + kstep; const char* b3 = b2 + kstep;
            if constexpr (SP2) {
            PG8_LDB(B0, 0, 0); PG8_LDB(B1, 0, 1); PG8_SCHED; PG8_LDA(At, 0, 0); PG8_STA(PG8_SA(1, 1), a1, 1, false);
            PG8_WAIT_V(8); PG8_WAIT_L(0); PG8_BAR; PG8_MMA(0, 0, At, B0); PG8_MMA(0, 1, At, B1); PG8_BAR; PG8_SCHED;
            PG8_LDA(At, 0, 1); PG8_STAGE(PG8_SB(0, 0), b2, voffB); PG8_STAGE(PG8_SB(0, 1), b2 + hstepB, voffB); PG8_STA(PG8_SA(0, 0), a2, 0, last);
            PG8_WAIT_V(8); PG8_WAIT_L(0); PG8_BAR; PG8_MMA(1, 0, At, B0); PG8_MMA(1, 1, At, B1); PG8_BAR; PG8_SCHED;
            PG8_LDB(B0, 1, 0); PG8_LDB(B1, 1, 1); PG8_SCHED; PG8_LDA(At, 1, 0); PG8_STA(PG8_SA(0, 1), a2, 1, last);
            PG8_WAIT_V(8); PG8_WAIT_L(0); PG8_BAR; PG8_MMA(0, 0, At, B0); PG8_MMA(0, 1, At, B1); PG8_BAR; PG8_SCHED;
            PG8_LDA(At, 1, 1); PG8_STAGE(PG8_SB(1, 0), b3, voffB); PG8_STAGE(PG8_SB(1, 1), b3 + hstepB, voffB); PG8_STA(PG8_SA(1, 0), a3, 0, last);
            PG8_WAIT_V(8); PG8_WAIT_L(0); PG8_BAR; PG8_MMA(1, 0, At, B0); PG8_MMA(1, 1, At, B1); PG8_BAR; PG8_SCHED;
            } else {
            PG8_LDB(B0, 0, 0); PG8_SCHED; PG8_LDA(At, 0, 0); PG8_STAGE(PG8_SA(1, 1), a1 + hstepA, voffA);
            PG8_WAIT_L(8); PG8_BAR; PG8_WAIT_L(0); PG8_MMA(0, 0, At, B0); PG8_BAR; PG8_SCHED;
            PG8_LDB(B1, 0, 1); PG8_STAGE(PG8_SB(0, 0), b2, voffB);
            PG8_BAR; PG8_WAIT_L(0); PG8_MMA(0, 1, At, B1); PG8_BAR;
            PG8_LDA(At, 0, 1); PG8_STAGE(PG8_SA(0, 0), a2, voffA);
            PG8_BAR; PG8_WAIT_L(0); PG8_MMA(1, 0, At, B0); PG8_BAR; PG8_SCHED;
            PG8_STAGE(PG8_SB(0, 1), b2 + hstepB, voffB);
            PG8_WAIT_V(6); PG8_BAR; PG8_MMA(1, 1, At, B1); PG8_BAR;
            PG8_LDB(B0, 1, 0); PG8_SCHED; PG8_LDA(At, 1, 0); PG8_STAGE(PG8_SA(0, 1), a2 + hstepA, voffA);
            PG8_WAIT_L(8); PG8_BAR; PG8_WAIT_L(0); PG8_MMA(0, 0, At, B0); PG8_BAR; PG8_SCHED;
            PG8_LDB(B1, 1, 1); PG8_STAGE(PG8_SB(1, 0), b3, voffB);
            PG8_BAR; PG8_WAIT_L(0); PG8_MMA(0, 1, At, B1); PG8_BAR;
            PG8_LDA(At, 1, 1); PG8_STAGE(PG8_SA(1, 0), a3, voffA);
            PG8_BAR; PG8_WAIT_L(0); PG8_MMA(1, 0, At, B0); PG8_BAR; PG8_SCHED;
            PG8_STAGE(PG8_SB(1, 1), b3 + hstepB, voffB);
            PG8_WAIT_V(6); PG8_BAR; PG8_MMA(1, 1, At, B1); PG8_BAR;
            }
        }
        if constexpr (ALIGN_EPI) { if (wr == 0) PG8_BAR; }
        asm volatile("s_nop 15\n\ts_nop 15" : "+v"(acc[0][0][0][0]), "+v"(acc[0][0][0][1]), "+v"(acc[0][0][1][0]), "+v"(acc[0][0][1][1]), "+v"(acc[0][0][2][0]), "+v"(acc[0][0][2][1]), "+v"(acc[0][0][3][0]), "+v"(acc[0][0][3][1]), "+v"(acc[0][1][0][0]), "+v"(acc[0][1][0][1]), "+v"(acc[0][1][1][0]), "+v"(acc[0][1][1][1]), "+v"(acc[0][1][2][0]), "+v"(acc[0][1][2][1]), "+v"(acc[0][1][3][0]), "+v"(acc[0][1][3][1]), "+v"(acc[1][0][0][0]), "+v"(acc[1][0][0][1]), "+v"(acc[1][0][1][0]), "+v"(acc[1][0][1][1]), "+v"(acc[1][0][2][0]), "+v"(acc[1][0][2][1]), "+v"(acc[1][0][3][0]), "+v"(acc[1][0][3][1]), "+v"(acc[1][1][0][0]), "+v"(acc[1][1][0][1]), "+v"(acc[1][1][1][0]), "+v"(acc[1][1][1][1]), "+v"(acc[1][1][2][0]), "+v"(acc[1][1][2][1]), "+v"(acc[1][1][3][0]), "+v"(acc[1][1][3][1]) :: "memory");
        if constexpr (!Epi::AFTER_DRAIN) E(acc, cur, wr, wc, fr, fq);
        if (!has_next) break;
#pragma unroll
        for (int a = 0; a < 2; ++a)
#pragma unroll
            for (int b = 0; b < 2; ++b)
#pragma unroll
                for (int m = 0; m < 4; ++m)
#pragma unroll
                    for (int n = 0; n < 2; ++n) acc[a][b][m][n] = (f32x4){0.f, 0.f, 0.f, 0.f};
        cur = nxt; cA = nA; cB = nB; ++ui;
        if constexpr (GA) { voffA[0] = nvA[0]; voffA[1] = nvA[1]; voffA1[0] = nvA1[0]; voffA1[1] = nvA1[1]; }
        if constexpr (ALIGN_EPI) { if (wr == 1) PG8_BAR; }
    }
    PG8_WAIT_V(0);
    if constexpr (!ALIGN_EPI) { if (wr == 0) PG8_BAR; }
    PG8_BAR;
    if constexpr (Epi::AFTER_DRAIN) E.fused(acc, cur, wr, wc, fr, fq, lds, wid, lane);
#undef PG8_SA
#undef PG8_SB
#undef PG8_STAGE
#undef PG8_STA
#undef PG8_GA_LOAD
#undef PG8_LDA
#undef PG8_LDB
#undef PG8_MMA
#undef PG8_WAIT_V
#undef PG8_WAIT_L
#undef PG8_BAR
#undef PG8_SCHED
}

typedef f32x4 Acc[2][2][4][2];
__device__ __forceinline__ unsigned cvt_pk_bf16(float lo, float hi) { unsigned r; asm volatile("v_cvt_pk_bf16_f32 %0, %1, %2" : "=v"(r) : "v"(lo), "v"(hi)); return r; }
__device__ __forceinline__ unsigned cvt_pk_bf16_t(float lo, float hi) { unsigned r; asm volatile("s_nop 0\n\tv_cvt_pk_bf16_f32 %0, %1, %2" : "=v"(r) : "v"(lo), "v"(hi)); return r; }

#ifndef EMU_F8
#define EMU_F8 0
#endif
struct EpiBf16 {
    static constexpr bool PERM = true, AFTER_DRAIN = false;
    us* O; int ldc; int emu;
    __device__ __forceinline__ void operator()(const Acc& acc_, const Unit& u, int wr, int wc, int fr, int fq) const {
        Acc acc;
#pragma unroll
        for (int a = 0; a < 2; ++a)
#pragma unroll
            for (int b = 0; b < 2; ++b)
#pragma unroll
                for (int m = 0; m < 4; ++m)
#pragma unroll
                    for (int n = 0; n < 2; ++n) acc[a][b][m][n] = acc_[a][b][m][n];
        if (EMU_F8 && emu && ((u.pn >= 4 && u.pn <= 10) || (u.pn >= 12 && u.pn <= 14))) {
#pragma unroll
            for (int a = 0; a < 2; ++a)
#pragma unroll
                for (int b = 0; b < 2; ++b)
#pragma unroll
                    for (int m = 0; m < 4; ++m)
#pragma unroll
                        for (int n = 0; n < 2; ++n) { const int w0 = __builtin_amdgcn_cvt_pk_fp8_f32(acc[a][b][m][n][0], acc[a][b][m][n][1], 0, false), w1 = __builtin_amdgcn_cvt_pk_fp8_f32(acc[a][b][m][n][2], acc[a][b][m][n][3], 0, false);
                            acc[a][b][m][n] = (f32x4){__builtin_amdgcn_cvt_f32_fp8(w0, 0), __builtin_amdgcn_cvt_f32_fp8(w0, 1), __builtin_amdgcn_cvt_f32_fp8(w1, 0), __builtin_amdgcn_cvt_f32_fp8(w1, 1)}; }
        }
        const int row0 = u.pm * BM + wr * 64 + fr, col0 = u.pn * BM + wc * 32 + 8 * fq;
#pragma unroll
        for (int ai = 0; ai < 2; ++ai)
#pragma unroll
            for (int m = 0; m < 4; ++m) { us* rowp = O + (size_t)(row0 + ai * HALF + m * 16) * ldc + col0;
#pragma unroll
                for (int bj = 0; bj < 2; ++bj) { const f32x4 v0 = acc[ai][bj][m][0], v1 = acc[ai][bj][m][1];
                    u32x4 w; w.x = cvt_pk_bf16(v0[0], v0[1]); w.y = cvt_pk_bf16(v0[2], v0[3]); w.z = cvt_pk_bf16(v1[0], v1[1]); w.w = cvt_pk_bf16(v1[2], v1[3]);
                    *(u32x4*)(rowp + bj * HALF) = w; } }
    }
};
struct EpiScaleRow {
    static constexpr bool PERM = true, AFTER_DRAIN = false;
    us* O; int ldc; const float* rs;
    __device__ __forceinline__ void operator()(const Acc& acc, const Unit& u, int wr, int wc, int fr, int fq) const {
        const int row0 = u.pm * BM + wr * 64 + fr, col0 = u.pn * BM + wc * 32 + 8 * fq;
        float sv[2][4];
#pragma unroll
        for (int ai = 0; ai < 2; ++ai)
#pragma unroll
            for (int m = 0; m < 4; ++m) sv[ai][m] = rs[row0 + ai * HALF + m * 16];
        __builtin_amdgcn_sched_barrier(0);
#pragma unroll
        for (int ai = 0; ai < 2; ++ai)
#pragma unroll
            for (int m = 0; m < 4; ++m) { const int row = row0 + ai * HALF + m * 16; const float s = sv[ai][m]; us* rowp = O + (size_t)row * ldc + col0;
#pragma unroll
                for (int bj = 0; bj < 2; ++bj) { const f32x4 v0 = acc[ai][bj][m][0] * s, v1 = acc[ai][bj][m][1] * s;
                    u32x4 w; w.x = cvt_pk_bf16(v0[0], v0[1]); w.y = cvt_pk_bf16(v0[2], v0[3]); w.z = cvt_pk_bf16(v1[0], v1[1]); w.w = cvt_pk_bf16(v1[2], v1[3]);
                    *(u32x4*)(rowp + bj * HALF) = w; } }
    }
};
struct EpiScaleCol {
    static constexpr bool PERM = true, AFTER_DRAIN = false;
    us* O; int ldc; const float* cs;
    __device__ __forceinline__ void operator()(const Acc& acc, const Unit& u, int wr, int wc, int fr, int fq) const {
        const int row0 = u.pm * BM + wr * 64 + fr, col0 = u.pn * BM + wc * 32 + 8 * fq;
        f32x4 sc[2][2];
#pragma unroll
        for (int bj = 0; bj < 2; ++bj)
#pragma unroll
            for (int n = 0; n < 2; ++n) sc[bj][n] = *(const f32x4*)(cs + col0 + bj * HALF + 4 * n);
#pragma unroll
        for (int ai = 0; ai < 2; ++ai)
#pragma unroll
            for (int m = 0; m < 4; ++m) { us* rowp = O + (size_t)(row0 + ai * HALF + m * 16) * ldc + col0;
#pragma unroll
                for (int bj = 0; bj < 2; ++bj) { const f32x4 v0 = acc[ai][bj][m][0] * sc[bj][0], v1 = acc[ai][bj][m][1] * sc[bj][1];
                    u32x4 w; w.x = cvt_pk_bf16(v0[0], v0[1]); w.y = cvt_pk_bf16(v0[2], v0[3]); w.z = cvt_pk_bf16(v1[0], v1[1]); w.w = cvt_pk_bf16(v1[2], v1[3]);
                    *(u32x4*)(rowp + bj * HALF) = w; } }
    }
};
struct EpiQRope {
    static constexpr bool PERM = true, AFTER_DRAIN = false;
    us* O; const float* rs; const float* cstab;
    __device__ __forceinline__ void operator()(const Acc& acc, const Unit& u, int wr, int wc, int fr, int fq) const {
        const int row0 = u.pm * BM + wr * 64 + fr, col0 = u.pn * BM + wc * 32 + 8 * fq;
        const int w0 = col0 % 192, w1 = (col0 + HALF) % 192;
        const int ropeh = w0 >= 128 ? 0 : (w1 >= 128 ? 1 : -1), wsel = w0 >= 128 ? w0 : (w1 >= 128 ? w1 : 128);
#pragma unroll
        for (int ai = 0; ai < 2; ++ai) {
            float sv[4]; f32x4 ca[4], cb[4];
#pragma unroll
            for (int m = 0; m < 4; ++m) { const int row = row0 + ai * HALF + m * 16; sv[m] = rs[row];
                const float* cp = cstab + ((size_t)row * 32 + (wsel - 128) / 2) * 2; ca[m] = *(const f32x4*)cp; cb[m] = *(const f32x4*)(cp + 4); }
            __builtin_amdgcn_sched_barrier(0);
#pragma unroll
            for (int m = 0; m < 4; ++m) { const int row = row0 + ai * HALF + m * 16; const float s = sv[m]; us* rowp = O + (size_t)row * 768 + col0;
#pragma unroll
                for (int bj = 0; bj < 2; ++bj) { f32x4 v0 = acc[ai][bj][m][0] * s, v1 = acc[ai][bj][m][1] * s;
                    if (bj == ropeh) {
                        const f32x4 c01 = ca[m], c23 = cb[m];
                        const f32x4 a = v0, b = v1;
                        v0[0] = a[0] * c01[0] - a[1] * c01[1]; v0[1] = a[0] * c01[1] + a[1] * c01[0];
                        v0[2] = a[2] * c01[2] - a[3] * c01[3]; v0[3] = a[2] * c01[3] + a[3] * c01[2];
                        v1[0] = b[0] * c23[0] - b[1] * c23[1]; v1[1] = b[0] * c23[1] + b[1] * c23[0];
                        v1[2] = b[2] * c23[2] - b[3] * c23[3]; v1[3] = b[2] * c23[3] + b[3] * c23[2];
                    }
                    u32x4 w; w.x = cvt_pk_bf16(v0[0], v0[1]); w.y = cvt_pk_bf16(v0[2], v0[3]); w.z = cvt_pk_bf16(v1[0], v1[1]); w.w = cvt_pk_bf16(v1[2], v1[3]);
                    *(u32x4*)(rowp + bj * HALF) = w; } }
            __builtin_amdgcn_sched_barrier(0);
        }
    }
};
template <bool IN_F32>
struct EpiResid {
    static constexpr bool PERM = true, AFTER_DRAIN = false;
    const float* xin32; us* xb; const float* gate;
    int gstride;
    __device__ __forceinline__ void operator()(const Acc& acc, const Unit& u, int wr, int wc, int fr, int fq) const {
        const int row0 = u.pm * BM + wr * 64 + fr, col0 = u.pn * BM + wc * 32 + 8 * fq;
        const float* gp = gate + (size_t)((u.pm * BM) >> 11) * gstride + col0;
        f32x4 gv[2][2];
#pragma unroll
        for (int bj = 0; bj < 2; ++bj)
#pragma unroll
            for (int n = 0; n < 2; ++n) gv[bj][n] = *(const f32x4*)(gp + bj * HALF + 4 * n);
#pragma unroll
        for (int ai = 0; ai < 2; ++ai)
#pragma unroll
            for (int mh = 0; mh < 2; ++mh) {
                f32x4 x0[2][2], x1[2][2];
#pragma unroll
                for (int mm = 0; mm < 2; ++mm) { const int m = 2 * mh + mm; const size_t ro = (size_t)(row0 + ai * HALF + m * 16) * D + col0;
#pragma unroll
                    for (int bj = 0; bj < 2; ++bj) {
                        if (IN_F32) { x0[mm][bj] = *(const f32x4*)(xin32 + ro + bj * HALF); x1[mm][bj] = *(const f32x4*)(xin32 + ro + bj * HALF + 4); }
                        else { const u32x4 xw = *(const u32x4*)(xb + ro + bj * HALF);
                            x0[mm][bj] = (f32x4){__uint_as_float(xw.x << 16), __uint_as_float(xw.x & 0xFFFF0000u), __uint_as_float(xw.y << 16), __uint_as_float(xw.y & 0xFFFF0000u)};
                            x1[mm][bj] = (f32x4){__uint_as_float(xw.z << 16), __uint_as_float(xw.z & 0xFFFF0000u), __uint_as_float(xw.w << 16), __uint_as_float(xw.w & 0xFFFF0000u)}; } } }
                __builtin_amdgcn_sched_barrier(0);
#pragma unroll
                for (int mm = 0; mm < 2; ++mm) { const int m = 2 * mh + mm; const size_t ro = (size_t)(row0 + ai * HALF + m * 16) * D + col0;
#pragma unroll
                    for (int bj = 0; bj < 2; ++bj) {
                        const f32x4 v0 = x0[mm][bj] + gv[bj][0] * acc[ai][bj][m][0], v1 = x1[mm][bj] + gv[bj][1] * acc[ai][bj][m][1];
                        u32x4 w; w.x = cvt_pk_bf16(v0[0], v0[1]); w.y = cvt_pk_bf16(v0[2], v0[3]); w.z = cvt_pk_bf16(v1[0], v1[1]); w.w = cvt_pk_bf16(v1[2], v1[3]);
                        *(u32x4*)(xb + ro + bj * HALF) = w; } }
                __builtin_amdgcn_sched_barrier(0);
            }
    }
};
template <bool IN_F32, bool OUT16>
struct EpiResidNorm {
    static constexpr bool PERM = true, AFTER_DRAIN = true;
    const float* xin32; us* xb; const float* gate; int gstride;
    const float* g; const float* modb; int sh_off, sc_off;
    unsigned char* h8; us* h16;
    unsigned* slots; unsigned* cnt; unsigned* tmo;
    __device__ __forceinline__ void operator()(const Acc&, const Unit&, int, int, int, int) const {}
    __device__ __forceinline__ void fused(Acc& acc, const Unit& u, int wr, int wc, int fr, int fq, LAS unsigned char* lds, int wid, int lane) const {
        const int row0 = u.pm * BM + wr * 64 + fr, col0 = u.pn * BM + wc * 32 + 8 * fq, bb = (u.pm * BM) >> 11;
        LAS float* P = (LAS float*)lds;
        LAS float* S = (LAS float*)(lds + 4096);
        {
            const float* gp = gate + (size_t)bb * gstride + col0;
            f32x4 gv[2][2];
#pragma unroll
            for (int bj = 0; bj < 2; ++bj)
#pragma unroll
                for (int n = 0; n < 2; ++n) gv[bj][n] = *(const f32x4*)(gp + bj * HALF + 4 * n);
#pragma unroll
            for (int ai = 0; ai < 2; ++ai)
#pragma unroll
                for (int mh = 0; mh < 2; ++mh) {
                    f32x4 x0[2][2], x1[2][2];
#pragma unroll
                    for (int mm = 0; mm < 2; ++mm) { const int m = 2 * mh + mm; const size_t ro = (size_t)(row0 + ai * HALF + m * 16) * D + col0;
#pragma unroll
                        for (int bj = 0; bj < 2; ++bj) {
                            if (IN_F32) { x0[mm][bj] = *(const f32x4*)(xin32 + ro + bj * HALF); x1[mm][bj] = *(const f32x4*)(xin32 + ro + bj * HALF + 4); }
                            else { const u32x4 xw = *(const u32x4*)(xb + ro + bj * HALF);
                                x0[mm][bj] = (f32x4){__uint_as_float(xw.x << 16), __uint_as_float(xw.x & 0xFFFF0000u), __uint_as_float(xw.y << 16), __uint_as_float(xw.y & 0xFFFF0000u)};
                                x1[mm][bj] = (f32x4){__uint_as_float(xw.z << 16), __uint_as_float(xw.z & 0xFFFF0000u), __uint_as_float(xw.w << 16), __uint_as_float(xw.w & 0xFFFF0000u)}; } } }
                    __builtin_amdgcn_sched_barrier(0);
#pragma unroll
                    for (int mm = 0; mm < 2; ++mm) { const int m = 2 * mh + mm; const size_t ro = (size_t)(row0 + ai * HALF + m * 16) * D + col0;
#pragma unroll
                        for (int bj = 0; bj < 2; ++bj) {
                            const f32x4 v0 = x0[mm][bj] + gv[bj][0] * acc[ai][bj][m][0], v1 = x1[mm][bj] + gv[bj][1] * acc[ai][bj][m][1];
                            u32x4 w; w.x = cvt_pk_bf16(v0[0], v0[1]); w.y = cvt_pk_bf16(v0[2], v0[3]); w.z = cvt_pk_bf16(v1[0], v1[1]); w.w = cvt_pk_bf16(v1[2], v1[3]);
                            *(u32x4*)(xb + ro + bj * HALF) = w;
                            acc[ai][bj][m][0] = (f32x4){__uint_as_float(w.x << 16), __uint_as_float(w.x & 0xFFFF0000u), __uint_as_float(w.y << 16), __uint_as_float(w.y & 0xFFFF0000u)};
                            acc[ai][bj][m][1] = (f32x4){__uint_as_float(w.z << 16), __uint_as_float(w.z & 0xFFFF0000u), __uint_as_float(w.w << 16), __uint_as_float(w.w & 0xFFFF0000u)}; } }
                    __builtin_amdgcn_sched_barrier(0);
                }
        }
#pragma unroll
        for (int ai = 0; ai < 2; ++ai)
#pragma unroll
            for (int m = 0; m < 4; ++m) { float sq = 0.f;
#pragma unroll
                for (int bj = 0; bj < 2; ++bj)
#pragma unroll
                    for (int n = 0; n < 2; ++n) { const f32x4 x = acc[ai][bj][m][n]; sq += (x[0] * x[0] + x[1] * x[1]) + (x[2] * x[2] + x[3] * x[3]); }
                sq = rows_sum(sq);
                if (fq == 0) P[(ai * HALF + wr * 64 + m * 16 + fr) * 4 + wc] = sq; }
        asm volatile("s_waitcnt lgkmcnt(0)" ::: "memory"); __builtin_amdgcn_s_barrier(); asm volatile("" ::: "memory");
        const int row = wid * 32 + (lane & 31);
        unsigned* srow = slots + ((size_t)u.pm * BM + row) * 8;
        if (lane < 32) { const f32x4 p4 = *(const LAS f32x4*)(P + row * 4);
            __hip_atomic_store(srow + u.pn, __float_as_uint((p4[0] + p4[1]) + (p4[2] + p4[3])), __ATOMIC_RELAXED, __HIP_MEMORY_SCOPE_AGENT); }
        asm volatile("s_waitcnt vmcnt(0)" ::: "memory");
        if (lane == 0) (void)__hip_atomic_fetch_add(cnt + 64 * u.pm, 1u, __ATOMIC_RELAXED, __HIP_MEMORY_SCOPE_AGENT);
        f32x4 gam[2][2], shv[2][2];
#pragma unroll
        for (int bj = 0; bj < 2; ++bj)
#pragma unroll
            for (int n = 0; n < 2; ++n) { const int col = col0 + bj * HALF + 4 * n; const float* mb = modb + (size_t)bb * 12288;
                gam[bj][n] = *(const f32x4*)(g + col) * (1.0f + *(const f32x4*)(mb + sc_off + col)); shv[bj][n] = *(const f32x4*)(mb + sh_off + col); }
        if (wid == 0) { unsigned sp = 0;
            while ((unsigned)__builtin_amdgcn_readfirstlane(__hip_atomic_load(cnt + 64 * u.pm, __ATOMIC_RELAXED, __HIP_MEMORY_SCOPE_AGENT)) < 64u) {
                __builtin_amdgcn_s_sleep(1);
                if ((++sp & 255u) == 0u) { if (__hip_atomic_load(tmo, __ATOMIC_RELAXED, __HIP_MEMORY_SCOPE_AGENT)) break; if (sp > XB_SPIN_CAP) { if (lane == 0) atomicAdd(tmo, 1u); break; } } }
            __builtin_amdgcn_fence(__ATOMIC_ACQUIRE, "agent");
            asm volatile("s_waitcnt vmcnt(0)" ::: "memory"); }
        asm volatile("" ::: "memory"); __builtin_amdgcn_s_barrier(); asm volatile("" ::: "memory");
        if (lane < 32) { float tot = 0.f;
#pragma unroll
            for (int t = 0; t < 8; ++t) tot += __uint_as_float(__hip_atomic_load(srow + t, __ATOMIC_RELAXED, __HIP_MEMORY_SCOPE_AGENT));
            S[row] = rsqrtf(tot * (1.0f / D) + EPS); }
        asm volatile("s_waitcnt vmcnt(0) lgkmcnt(0)" ::: "memory"); __builtin_amdgcn_s_barrier(); asm volatile("" ::: "memory");
#pragma unroll
        for (int ai = 0; ai < 2; ++ai)
#pragma unroll
            for (int m = 0; m < 4; ++m) { const float rstd = S[ai * HALF + wr * 64 + m * 16 + fr]; const size_t ro = (size_t)(row0 + ai * HALF + m * 16) * D + col0;
#pragma unroll
                for (int bj = 0; bj < 2; ++bj) { const f32x4 h0 = acc[ai][bj][m][0] * rstd * gam[bj][0] + shv[bj][0], h1 = acc[ai][bj][m][1] * rstd * gam[bj][1] + shv[bj][1];
                    u32x2 w8; w8.x = pk4_fp8(h0[0], h0[1], h0[2], h0[3]); w8.y = pk4_fp8(h1[0], h1[1], h1[2], h1[3]);
                    *(u32x2*)(h8 + ro + bj * HALF) = w8;
                    if (OUT16) { u32x4 w; w.x = cvt_pk_bf16(h0[0], h0[1]); w.y = cvt_pk_bf16(h0[2], h0[3]); w.z = cvt_pk_bf16(h1[0], h1[1]); w.w = cvt_pk_bf16(h1[2], h1[3]); *(u32x4*)(h16 + ro + bj * HALF) = w; } } }
    }
};
template <bool SIG>
struct EpiSwiglu {
    static constexpr bool PERM = true, AFTER_DRAIN = false;
    us* O; int ldc; unsigned* cnt; unsigned long long emlo; unsigned emhi;
    __device__ __forceinline__ u32x2 row8(const Acc& acc, int ai, int m) const {
        f32x4 r0, r1;
#pragma unroll
        for (int j = 0; j < 4; ++j) { const float g0 = acc[ai][0][m][0][j], g1 = acc[ai][0][m][1][j];
            r0[j] = g0 * __builtin_amdgcn_rcpf(1.0f + __expf(-g0)) * acc[ai][1][m][0][j]; r1[j] = g1 * __builtin_amdgcn_rcpf(1.0f + __expf(-g1)) * acc[ai][1][m][1][j]; }
        u32x2 w; w.x = pk4_fp8(r0[0], r0[1], r0[2], r0[3]); w.y = pk4_fp8(r1[0], r1[1], r1[2], r1[3]); return w;
    }
    __device__ __forceinline__ void operator()(const Acc& acc, const Unit& u, int wr, int wc, int fr, int fq) const {
        const int row0 = u.pm * BM + wr * 64 + fr;
        if (!SIG) {
            const int col0 = u.pn * HALF + wc * 32 + 8 * fq;
#pragma unroll
            for (int ai = 0; ai < 2; ++ai)
#pragma unroll
                for (int m = 0; m < 4; ++m) *(u32x2*)((unsigned char*)O + (size_t)(row0 + ai * HALF + m * 16) * ldc + col0) = row8(acc, ai, m);
        } else {
            const bool early = u.pm < 64 ? ((emlo >> u.pm) & 1ull) != 0ull : ((emhi >> (u.pm & 31)) & 1u) != 0u;
            const int col0 = u.pn * HALF + wc * 32 + 16 * (fq >> 1);
#pragma unroll
            for (int ai = 0; ai < 2; ++ai)
#pragma unroll
                for (int mp = 0; mp < 2; ++mp) { const u32x2 w0 = row8(acc, ai, 2 * mp), w1 = row8(acc, ai, 2 * mp + 1);
                    const auto sx = __builtin_amdgcn_permlane16_swap(w0.x, w1.x, false, false), sy = __builtin_amdgcn_permlane16_swap(w0.y, w1.y, false, false);
                    u32x4 w; w.x = sx[0]; w.y = sy[0]; w.z = sx[1]; w.w = sy[1];
                    unsigned char* rowp = (unsigned char*)O + (size_t)(row0 + ai * HALF + (2 * mp + (fq & 1)) * 16) * ldc + col0;
                    if (early) asm volatile("global_store_dwordx4 %0, %1, off sc1\n\ts_nop 1" :: "v"(rowp), "v"(w) : "memory");
                    else *(u32x4*)rowp = w; }
            if (early) { asm volatile("s_waitcnt vmcnt(0)" ::: "memory");
                if (fr == 0 && fq == 0) (void)__hip_atomic_fetch_add(moe_cnt(cnt, u.pm), 1u, __ATOMIC_RELAXED, __HIP_MEMORY_SCOPE_AGENT); }
        }
    }
};
}

struct Args {
    const float* in[25];
    float* out;
    unsigned char* ws;
    int lo, hi;
    int use_bar; int pad_;
};
enum { I_X = 0, I_C, I_POS, I_ADAW, I_ADAB, I_N1G, I_N2G, I_WIN, I_QNG, I_KVNG, I_WUQ, I_WUKV, I_GWG, I_GBG, I_GNG, I_WOUT, I_FWG, I_FWU, I_FWD,
       I_RW, I_RB, I_MWG, I_MWU, I_MWD, I_FNG };

struct Ctx {
    LAS unsigned char* lds; int tid, lane, wave, G, bid;
};

struct CvtJob { const float* src; us* dst; const float* kscale; int K, N, map, tk, tn, fp8; };
__device__ __forceinline__ int cvt_row(int map, int n) {
    if (map == 0) return n;
    if (map == 1) return (n >> 7) * 256 + (n & 127);
    if (map == 2) return (n >> 7) * 256 + 128 + (n & 127);
    if (map == 3) { const int h = n / 192, j = n % 192; if (j < 128) return n; const int r = j - 128; return h * 192 + 128 + (r < 32 ? 2 * r : 2 * (r - 32) + 1); }
    if (map == 4) { const int h = n >> 8, j = n & 255; return j < 128 ? h * 128 + j : 512 + h * 128 + (j - 128); }
    int col;
    if (n < 512) col = C_CQ + n; else if (n < 768) col = C_CKV + (n - 512); else if (n < 832) col = C_KPE + (n - 768); else if (n < 1344) col = C_GQ + (n - 832);
    else if (n < 1856) col = C_GK + (n - 1344); else if (n < 2880) col = C_GV + (n - 1856); else if (n < 2896) col = C_GLOW + (n - 2880); else if (n < 3920) col = C_GR + (n - 2896); else col = n;
    if (map == 5) return col >= NP8 ? col - NP8 : -1;
    return col < NP8 ? col : -1;
}
constexpr int CT_WIN = 8 * 42,
               CT_WUQ = 2 * 6, CT_WUKV = 1 * 8, CT_WOUT = 8 * 16, CT_FGU = 8 * 44, CT_FD = 22 * 16, CT_MGU = 8 * 22, CT_MD = 11 * 16;
constexpr int CVT_TILES = 2 * CT_WIN + 2 * CT_WUQ + 2 * CT_WUKV + 2 * CT_WOUT + 2 * CT_FGU + CT_FD + 16 * CT_MGU + 8 * CT_MD;
constexpr int MOD_ITEMS = 192, CS_ITEMS = 512;

__device__ __forceinline__ void cvt_decode(int t, const Args& a, CvtJob& j) {
    unsigned char* ws = a.ws;
    int ntn;
    j.fp8 = 0;
    if (t < 2 * CT_WIN) { const int l = t / CT_WIN; t %= CT_WIN; j.src = a.in[I_WIN] + (size_t)l * D * DPROJ; j.kscale = nullptr; j.K = D; j.N = DPROJ;
        const int tk = t / 42, tt = t % 42;
        if (tt < 6) { j.dst = (us*)(ws + WS_WIN) + (size_t)l * (DPROJ_P - NP8) * D; j.map = 5; j.tn = 36 + tt; }
        else { j.dst = (us*)(ws + WS_WIN8 + (size_t)l * NP8 * D); j.map = 6; j.fp8 = 1; j.tn = tt - 6; }
        j.tk = tk; return; }
    else if ((t -= 2 * CT_WIN) < 2 * CT_WUQ) { const int l = t / CT_WUQ; t %= CT_WUQ; j.src = a.in[I_WUQ] + (size_t)l * 512 * 768; j.dst = (us*)(ws + WS_WUQ) + (size_t)l * 768 * 512; j.kscale = a.in[I_QNG] + l * 512; j.K = 512; j.N = 768; j.map = 3; ntn = 6; }
    else if ((t -= 2 * CT_WUQ) < 2 * CT_WUKV) { const int l = t / CT_WUKV; t %= CT_WUKV; j.src = a.in[I_WUKV] + (size_t)l * 256 * 1024; j.dst = (us*)(ws + WS_WUKV) + (size_t)l * 1024 * 256; j.kscale = a.in[I_KVNG] + l * 256; j.K = 256; j.N = 1024; j.map = 4; ntn = 8; }
    else if ((t -= 2 * CT_WUKV) < 2 * CT_WOUT) { const int l = t / CT_WOUT; t %= CT_WOUT; j.src = a.in[I_WOUT] + (size_t)l * D * D; j.dst = (us*)((unsigned char*)(ws + WS_WOUT) + (size_t)l * D * D); j.kscale = nullptr; j.K = D; j.N = D; j.map = 0; ntn = 16; j.fp8 = 1; }
    else if ((t -= 2 * CT_WOUT) < 2 * CT_FGU) { const int w = t / CT_FGU; t %= CT_FGU; j.src = a.in[w ? I_FWU : I_FWG]; j.dst = (us*)(ws + WS_WGU); j.kscale = nullptr; j.K = D; j.N = DFF; j.map = 1 + w; ntn = 44; j.fp8 = 1; }
    else if ((t -= 2 * CT_FGU) < CT_FD) { j.src = a.in[I_FWD]; j.dst = (us*)(ws + WS_WD); j.kscale = nullptr; j.K = DFF; j.N = D; j.map = 0; ntn = 16; j.fp8 = 1; }
    else if ((t -= CT_FD) < 16 * CT_MGU) { const int w = t / (8 * CT_MGU); t %= 8 * CT_MGU; const int e = t / CT_MGU; t %= CT_MGU;
        j.src = a.in[w ? I_MWU : I_MWG] + (size_t)e * D * DFFE; j.dst = (us*)((unsigned char*)(ws + WS_MGU) + (size_t)e * 2 * DFFE * D); j.kscale = nullptr; j.K = D; j.N = DFFE; j.map = 1 + w; ntn = 22; j.fp8 = 1; }
    else { t -= 16 * CT_MGU; const int e = t / CT_MD; t %= CT_MD; j.src = a.in[I_MWD] + (size_t)e * DFFE * D; j.dst = (us*)((unsigned char*)(ws + WS_MD) + (size_t)e * D * DFFE); j.kscale = nullptr; j.K = DFFE; j.N = D; j.map = 0; ntn = 16; j.fp8 = 1; }
    j.tk = t / ntn; j.tn = t % ntn;
}

struct CvtRegs { f32x4 r[16]; float sc[16]; };
__device__ __forceinline__ void cvt_load(const Ctx& c, const CvtJob& j, CvtRegs& R) {
    const int k0 = j.tk * 256, n0 = j.tn * 128;
    if (j.fp8) {
#pragma unroll
        for (int it = 0; it < 4; ++it) { const int idx = it * 512 + c.tid, kq = idx >> 5, nq = idx & 31; const float* p = j.src + (size_t)(k0 + 4 * kq) * j.N + n0 + 4 * nq;
#pragma unroll
            for (int u = 0; u < 4; ++u) R.r[4 * it + u] = (n0 + 4 * nq < j.N) ? __builtin_nontemporal_load((const f32x4*)(p + (size_t)u * j.N)) : (f32x4){0.f, 0.f, 0.f, 0.f}; }
        return;
    }
#pragma unroll
    for (int it = 0; it < 8; ++it) {
        const int idx = it * 512 + c.tid, kp = idx >> 5, nq = idx & 31, n = n0 + 4 * nq, k = k0 + 2 * kp;
        R.r[2 * it] = (f32x4){0.f, 0.f, 0.f, 0.f}; R.r[2 * it + 1] = R.r[2 * it];
        if (n < j.N) { R.r[2 * it] = __builtin_nontemporal_load((const f32x4*)(j.src + (size_t)k * j.N + n)); R.r[2 * it + 1] = __builtin_nontemporal_load((const f32x4*)(j.src + (size_t)(k + 1) * j.N + n)); }
        R.sc[2 * it] = 1.f; R.sc[2 * it + 1] = 1.f;
        if (j.kscale) { R.sc[2 * it] = j.kscale[k]; R.sc[2 * it + 1] = j.kscale[k + 1]; }
    }
}
__device__ __forceinline__ void cvt_store(const Ctx& c, const CvtJob& j, const CvtRegs& R) {
    LAS unsigned* W = (LAS unsigned*)c.lds;
    const int k0 = j.tk * 256, n0 = j.tn * 128;
    if (j.fp8) {
#pragma unroll
        for (int it = 0; it < 4; ++it) { const int idx = it * 512 + c.tid, kq = idx >> 5, nq = idx & 31, rp = (kq & 3) * 16 + (kq >> 2);
#pragma unroll
            for (int q = 0; q < 4; ++q) W[rp * 129 + q * 32 + nq] = pk4_fp8(R.r[4 * it][q] * 64.f, R.r[4 * it + 1][q] * 64.f, R.r[4 * it + 2][q] * 64.f, R.r[4 * it + 3][q] * 64.f); }
        __syncthreads();
        const int a16 = c.tid & 15, rsel = (c.tid >> 4) & 1, rest = c.tid >> 5;
#pragma unroll
        for (int ps = 0; ps < 4; ++ps) { const int nl = rsel * 64 + rest + 16 * ps, cp = (nl & 3) * 32 + (nl >> 2);
            u32x4 w; w.x = W[(0 * 16 + a16) * 129 + cp]; w.y = W[(1 * 16 + a16) * 129 + cp]; w.z = W[(2 * 16 + a16) * 129 + cp]; w.w = W[(3 * 16 + a16) * 129 + cp];
            const int n = n0 + nl; const int row = (n < j.N) ? cvt_row(j.map, n) : -1;
            if (row >= 0) *(u32x4*)((unsigned char*)j.dst + (size_t)row * j.K + k0 + 16 * a16) = w; }
        __syncthreads();
        return;
    }
#pragma unroll
    for (int it = 0; it < 8; ++it) {
        const int idx = it * 512 + c.tid, kp = idx >> 5, nq = idx & 31;
        const f32x4 r0 = R.r[2 * it] * R.sc[2 * it], r1 = R.r[2 * it + 1] * R.sc[2 * it + 1];
        const int rp = (kp & 3) * 32 + (kp >> 2);
#pragma unroll
        for (int q = 0; q < 4; ++q) W[rp * 128 + q * 32 + nq] = pk2(r0[q], r1[q]);
    }
    __syncthreads();
    const int a = c.tid & 31, nn = c.tid >> 5;
#pragma unroll
    for (int it = 0; it < 8; ++it) {
        const int nl = nn + 16 * it, n = n0 + nl, cp = (nl & 3) * 32 + (nl >> 2);
        u32x4 w;
        w.x = W[(0 * 32 + a) * 128 + cp]; w.y = W[(1 * 32 + a) * 128 + cp]; w.z = W[(2 * 32 + a) * 128 + cp]; w.w = W[(3 * 32 + a) * 128 + cp];
        int row = -1;
        if (n < j.N) row = cvt_row(j.map, n); else if (j.map == 5 && n < DPROJ_P) row = n - NP8;
        if (row >= 0) *(u32x4*)(j.dst + (size_t)row * j.K + k0 + 8 * a) = w;
    }
    __syncthreads();
}

__device__ __forceinline__ void mod_item(const Ctx& c, const Args& a, int item) {
    LAS float* ca = (LAS float*)c.lds;
    LAS float* red = (LAS float*)(c.lds + 32768);
    for (int i = c.tid; i < 4 * 2048; i += 512) ca[i] = siluf(a.in[I_C][i]);
    __syncthreads();
    const int l = item / 96, cb = item % 96, nq = c.tid & 31, kg = c.tid >> 5;
    const float* w = a.in[I_ADAW] + (size_t)l * D * 12288 + cb * 128 + 4 * nq;
    f32x4 acc[4];
#pragma unroll
    for (int b = 0; b < 4; ++b) acc[b] = (f32x4){0.f, 0.f, 0.f, 0.f};
#pragma unroll 1
    for (int kk = 0; kk < 128; kk += 16) {
        f32x4 wv[16];
#pragma unroll
        for (int u = 0; u < 16; ++u) wv[u] = __builtin_nontemporal_load((const f32x4*)(w + (size_t)(kg * 128 + kk + u) * 12288));
#pragma unroll
        for (int u = 0; u < 16; ++u)
#pragma unroll
            for (int b = 0; b < 4; ++b) acc[b] += wv[u] * ca[b * 2048 + kg * 128 + kk + u];
    }
#pragma unroll
    for (int b = 0; b < 4; ++b)
#pragma unroll
        for (int q = 0; q < 4; ++q) red[(kg * 4 + b) * 128 + 4 * nq + q] = acc[b][q];
    __syncthreads();
    { const int b = c.tid >> 7, col = c.tid & 127; float s = a.in[I_ADAB][l * 12288 + cb * 128 + col];
#pragma unroll
      for (int g = 0; g < 16; ++g) s += red[(g * 4 + b) * 128 + col];
      __hip_atomic_store((float*)(a.ws + WS_MOD) + ((size_t)l * 4 + b) * 12288 + cb * 128 + col, s, __ATOMIC_RELAXED, __HIP_MEMORY_SCOPE_AGENT); }
    asm volatile("s_waitcnt vmcnt(0)" ::: "memory");
    __syncthreads();
    if (l == 0 && c.tid == 0) (void)__hip_atomic_fetch_add((unsigned*)(a.ws + WS_NCNT) + 48, 1u, __ATOMIC_RELAXED, __HIP_MEMORY_SCOPE_AGENT);
}

__device__ __forceinline__ void cs_item(const Ctx& c, const Args& a, int item) {
    const int tok = item * 16 + (c.tid >> 5), i = c.tid & 31;
    const float pos = (float)((const int*)a.in[I_POS])[tok];
    const float inv = exp2f(-(float)i * (13.287712379549449f / 32.0f));
    const float ang = pos * inv;
    const double rev = (double)ang * 0.15915494309189535;
    const float fr = (float)(rev - rint(rev));
    float sn, cn;
    sn = __builtin_amdgcn_sinf(fr); cn = __builtin_amdgcn_cosf(fr);
    *(f32x2*)(a.ws + WS_CS + ((size_t)tok * 32 + i) * 8) = (f32x2){cn, sn};
}

constexpr int CVT_DEFER = 0, CVT_DEFER_UP = 512;
#ifndef PRO_REPS
#define PRO_REPS 1
#endif
__device__ __forceinline__ void cvt_range(const Ctx& c, const Args& a, int t0, int t1r, int first, int nb, int reps = 1) {
    int t = t0 + (c.bid - first); const int span = t1r - t0, t1 = t0 + span * reps;
    if (c.bid >= first && c.bid < first + nb && t < t1) {
        CvtJob jc; CvtRegs Rc; cvt_decode(t0 + (t - t0) % span, a, jc); cvt_load(c, jc, Rc);
#pragma unroll 1
        for (;;) {
            const int tn = t + nb; const bool more = tn < t1;
            CvtJob jn = jc; CvtRegs Rn;
            if (more) { cvt_decode(t0 + (tn - t0) % span, a, jn); cvt_load(c, jn, Rn); }
            cvt_store(c, jc, Rc);
            if (!more) break;
            jc = jn; t = tn;
#pragma unroll
            for (int i = 0; i < 16; ++i) { Rc.r[i] = Rn.r[i]; Rc.sc[i] = Rn.sc[i]; }
        }
    }
}
__device__ __forceinline__ void prologue_phase(const Ctx& c, const Args& a) {
    for (int itr = c.bid; itr < (MOD_ITEMS + CS_ITEMS) * PRO_REPS; itr += c.G) { const int it = itr % (MOD_ITEMS + CS_ITEMS);
        if (it < MOD_ITEMS) mod_item(c, a, it); else cs_item(c, a, it - MOD_ITEMS);
    }
    if (c.G == 256) {
        cvt_range(c, a, 0, 384, 192, 64, PRO_REPS);
        cvt_range(c, a, 384, CVT_TILES - 2 * CVT_DEFER - CVT_DEFER_UP, 0, 256, PRO_REPS);
    } else cvt_range(c, a, 0, CVT_TILES, 0, c.G);
}

template <bool XBF16> __device__ __forceinline__ f32x4 ldx4(const float* x, size_t idx) {
    if (!XBF16) return *(const f32x4*)(x + idx);
    const u32x2 w = *(const u32x2*)((const us*)x + idx);
    return (f32x4){__uint_as_float(w.x << 16), __uint_as_float(w.x & 0xFFFF0000u), __uint_as_float(w.y << 16), __uint_as_float(w.y & 0xFFFF0000u)};
}
template <bool ROUTER, int FP8OUT  , bool XBF16>
__device__ __forceinline__ void norm_phase(const Ctx& c, const Args& a, const float* x, const float* g, const float* mod_l, int sh_off, int sc_off, us* h, unsigned char* h8 = nullptr) {
    LAS float* rwT = (LAS float*)c.lds;
    if (ROUTER) { for (int i = c.tid; i < 8 * 2048; i += 512) rwT[(i & 7) * 2048 + (i >> 3)] = a.in[I_RW][i]; __syncthreads(); }
    for (int rg = c.bid * 8 + c.wave; rg < NTOK / 4; rg += c.G * 8) {
        const int row0 = rg * 4, b = row0 >> 11;
        const float* mb = mod_l + (size_t)b * 12288;
        f32x4 gam[8], shv[8], v[8], vn[8];
#pragma unroll
        for (int i = 0; i < 8; ++i) { const int col = (i * 64 + c.lane) * 4; gam[i] = *(const f32x4*)(g + col) * (1.0f + *(const f32x4*)(mb + sc_off + col)); shv[i] = *(const f32x4*)(mb + sh_off + col);
            v[i] = ldx4<XBF16>(x, (size_t)row0 * D + col); }
#pragma unroll
        for (int k = 0; k < 4; ++k) {
            const int row = row0 + k;
            if (k < 3) {
#pragma unroll
                for (int i = 0; i < 8; ++i) vn[i] = ldx4<XBF16>(x, (size_t)(row + 1) * D + (i * 64 + c.lane) * 4);
            }
            float ss = 0.f;
#pragma unroll
            for (int i = 0; i < 8; ++i) ss += v[i][0] * v[i][0] + v[i][1] * v[i][1] + v[i][2] * v[i][2] + v[i][3] * v[i][3];
            ss = wave_sum(ss);
            const float rstd = rsqrtf(ss * (1.0f / D) + EPS);
            float lg[8];
            if (ROUTER) {
#pragma unroll
                for (int e = 0; e < 8; ++e) lg[e] = 0.f;
            }
#pragma unroll
            for (int i = 0; i < 8; ++i) { const int col = (i * 64 + c.lane) * 4;
                const f32x4 hv = v[i] * rstd * gam[i] + shv[i];
                if (FP8OUT == 1) *(unsigned*)((unsigned char*)h + (size_t)row * D + col) = pk4_fp8(hv[0], hv[1], hv[2], hv[3]);
                if (FP8OUT == 2) *(unsigned*)(h8 + (size_t)row * D + col) = pk4_fp8(hv[0], hv[1], hv[2], hv[3]);
                if (FP8OUT != 1) { u32x2 w; w.x = pg8::cvt_pk_bf16(hv[0], hv[1]); w.y = pg8::cvt_pk_bf16(hv[2], hv[3]); *(u32x2*)(h + (size_t)row * D + col) = w; }
                if (ROUTER) {
#pragma unroll
                    for (int e = 0; e < 8; ++e) { const f32x4 r = *(const LAS f32x4*)(rwT + e * 2048 + col); lg[e] += hv[0] * r[0] + hv[1] * r[1] + hv[2] * r[2] + hv[3] * r[3]; }
                    __builtin_amdgcn_sched_barrier(0);
                }
            }
            if (ROUTER) {
#pragma unroll
                for (int e = 0; e < 8; ++e) lg[e] = wave_sum(lg[e]) + a.in[I_RB][e];
                int e0 = 0; float v0 = lg[0];
#pragma unroll
                for (int e = 1; e < 8; ++e) if (lg[e] > v0) { v0 = lg[e]; e0 = e; }
                int e1 = -1; float v1 = -3.0e38f;
#pragma unroll
                for (int e = 0; e < 8; ++e) if (e != e0 && lg[e] > v1) { v1 = lg[e]; e1 = e; }
                const float w1 = 1.0f / (1.0f + __expf(v0 - v1)), w0 = 1.0f - w1;
                if (c.lane == 0) { int* rt = (int*)(a.ws + WS_ROUTE); rt[row] = e0; rt[NTOK + row] = e1; ((float*)rt)[2 * NTOK + row] = w0; ((float*)rt)[3 * NTOK + row] = w1; }
            }
            if (k < 3) {
#pragma unroll
                for (int i = 0; i < 8; ++i) v[i] = vn[i];
            }
        }
    }
    if (ROUTER) __syncthreads();
}

__device__ __forceinline__ void rowstats_job(const Ctx& c, const Args& a) {
    const us* proj = (const us*)(a.ws + WS_PROJ); float* rs = (float*)(a.ws + WS_RSTD); us* kpe = (us*)(a.ws + WS_KPE);
    for (int tok = c.bid * 8 + c.wave; tok < NTOK; tok += c.G * 8) {
        const us* pr = proj + (size_t)tok * DPROJ_P;
        const bf16x8 q8 = ld8(pr + C_CQ + 8 * c.lane);
        float sq = 0.f, skv = 0.f;
#pragma unroll
        for (int j = 0; j < 8; ++j) { const float f = bf2f((us)q8[j]); sq += f * f; }
        if (c.lane < 32) { const bf16x8 k8 = ld8(pr + C_CKV + 8 * c.lane);
#pragma unroll
            for (int j = 0; j < 8; ++j) { const float f = bf2f((us)k8[j]); skv += f * f; } }
        sq = wave_sum(sq); skv = wave_sum(skv);
        if (c.lane == 0) { rs[tok] = rsqrtf(sq * (1.0f / 512.0f) + EPS); rs[NTOK + tok] = rsqrtf(skv * (1.0f / 256.0f) + EPS); }
        if (c.lane < 32) { const float x1 = bf2f(pr[C_KPE + c.lane]), x2 = bf2f(pr[C_KPE + 32 + c.lane]);
            const f32x2 cs = *(const f32x2*)(a.ws + WS_CS + ((size_t)tok * 32 + c.lane) * 8);
            *(unsigned*)(kpe + (size_t)tok * 64 + 2 * c.lane) = pk2(x1 * cs[0] - x2 * cs[1], x1 * cs[1] + x2 * cs[0]); }
    }
}
__device__ __forceinline__ void dvt_job(const Ctx& c, const Args& a) {
    const us* proj = (const us*)(a.ws + WS_PROJ); us* dvt = (us*)(a.ws + WS_DVT);
    for (int item = c.bid; item < 128; item += c.G) {
        const int b = item >> 5, t0 = (item & 31) * 64, d = c.tid & 127, tq = c.tid >> 7;
        unsigned w[8];
#pragma unroll
        for (int i = 0; i < 8; ++i) { const size_t r = (size_t)(b * SEQ + t0 + tq * 16 + 2 * i) * DPROJ_P + C_DV + d; w[i] = (unsigned)proj[r] | ((unsigned)proj[r + DPROJ_P] << 16); }
        us* dp = dvt + ((size_t)b * 128 + d) * SEQ + t0 + tq * 16;
        *(u32x4*)dp = (u32x4){w[0], w[1], w[2], w[3]}; *(u32x4*)(dp + 8) = (u32x4){w[4], w[5], w[6], w[7]};
    }
}
__device__ __forceinline__ void gla_a_job(const Ctx& c, const Args& a, int l) {
    const us* proj = (const us*)(a.ws + WS_PROJ);
    LAS us* kd = (LAS us*)c.lds;
    LAS us* vt = (LAS us*)(c.lds + 128 * 144);
    LAS float* gl = (LAS float*)(c.lds + 384 * 144);
    LAS float* part = (LAS float*)(c.lds + 384 * 144 + 4096);
    LAS us* kraw = (LAS us*)(c.lds + 65536);
    const float* wg = a.in[I_GWG] + (size_t)l * 16 * 512; const float* bg = a.in[I_GBG] + l * 512;
    const int k = c.tid & 127, tg = c.tid >> 7;
    us glr[2]; float w[16]; float bb = 0.f; u32x4 kc[2], vc[4];
#define GLA_LOAD(IT) do { const int it_ = (IT), h_ = it_ & 3; const size_t tok_ = (size_t)(it_ >> 7) * SEQ + ((it_ >> 2) & 31) * 64; \
        _Pragma("unroll") for (int i = 0; i < 2; ++i) { const int ii = c.tid + 512 * i; glr[i] = proj[(tok_ + (ii >> 4)) * DPROJ_P + C_GLOW + (ii & 15)]; } \
        _Pragma("unroll") for (int r = 0; r < 16; ++r) w[r] = wg[r * 512 + h_ * 128 + k]; \
        bb = bg[h_ * 128 + k]; \
        _Pragma("unroll") for (int i = 0; i < 2; ++i) { const int id = c.tid + 512 * i; kc[i] = *(const u32x4*)(proj + (tok_ + (id >> 4)) * DPROJ_P + C_GK + h_ * 128 + 8 * (id & 15)); } \
        _Pragma("unroll") for (int i = 0; i < 4; ++i) vc[i] = *(const u32x4*)(proj + (tok_ + c.lane) * DPROJ_P + C_GV + h_ * 256 + 8 * (c.wave + 8 * i)); } while (0)
    if (c.bid < 512) GLA_LOAD(c.bid);
    for (int item = c.bid; item < 512; item += c.G) {
        const int b = item >> 7, n = (item >> 2) & 31, h = item & 3; const size_t tok0 = (size_t)b * SEQ + n * 64;
        gl[c.tid] = bf2f(glr[0]); gl[c.tid + 512] = bf2f(glr[1]);
        __syncthreads();
        float la[16]; float run = 0.f;
#pragma unroll
        for (int tt = 0; tt < 16; ++tt) { const int t = tg * 16 + tt; float z = bb;
#pragma unroll
            for (int r = 0; r < 16; ++r) z += gl[t * 16 + r] * w[r];
            const float ls = fminf(z, 0.f) - __logf(1.0f + __expf(-fabsf(z)));
            run += ls * (1.0f / 16.0f); la[tt] = run; }
        part[tg * 128 + k] = run;
#pragma unroll
        for (int i = 0; i < 4; ++i) { const int v0 = 8 * (c.wave + 8 * i); const unsigned wv[4] = {vc[i].x, vc[i].y, vc[i].z, vc[i].w};
#pragma unroll
            for (int j = 0; j < 4; ++j) { vt[(v0 + 2 * j) * 72 + c.lane] = (us)(wv[j] & 0xFFFFu); vt[(v0 + 2 * j + 1) * 72 + c.lane] = (us)(wv[j] >> 16); } }
#pragma unroll
        for (int i = 0; i < 2; ++i) { const int id = c.tid + 512 * i; *(LAS u32x4*)(kraw + (id >> 4) * 136 + 8 * (id & 15)) = kc[i]; }
        __syncthreads();
        {   const float p0 = part[k], p1 = part[128 + k], p2 = part[256 + k], p3 = part[384 + k];
            const float total = (p0 + p1) + (p2 + p3);
            const float pre = (tg > 0 ? p0 : 0.f) + (tg > 1 ? p1 : 0.f) + (tg > 2 ? p2 : 0.f);
            if (tg == 0) ((float*)(a.ws + WS_DEC))[(size_t)item * 128 + k] = __expf(total);
#pragma unroll
            for (int tt = 0; tt < 16; ++tt) kd[k * 72 + tg * 16 + tt] = f2bf(bf2f(kraw[(tg * 16 + tt) * 136 + k]) * __expf(total - (pre + la[tt])));
        }
        __syncthreads();
        if (item + c.G < 512) GLA_LOAD(item + c.G);
        {
            const int fr = c.lane & 15, g = c.lane >> 4;
            f32x4 acc[8][2];
#pragma unroll
            for (int kb = 0; kb < 8; ++kb) { acc[kb][0] = (f32x4){0.f, 0.f, 0.f, 0.f}; acc[kb][1] = acc[kb][0]; }
#pragma unroll
            for (int ts = 0; ts < 2; ++ts) {
                bf16x8 bv[2];
#pragma unroll
                for (int vb = 0; vb < 2; ++vb) bv[vb] = *(const LAS bf16x8*)(vt + ((c.wave * 2 + vb) * 16 + fr) * 72 + ts * 32 + g * 8);
#pragma unroll
                for (int kb = 0; kb < 8; ++kb) { const bf16x8 av = *(const LAS bf16x8*)(kd + (kb * 16 + fr) * 72 + ts * 32 + g * 8);
                    acc[kb][0] = mfma16(av, bv[0], acc[kb][0]); acc[kb][1] = mfma16(av, bv[1], acc[kb][1]); }
            }
            us* out = (us*)(a.ws + WS_CKV) + (size_t)item * 256 * 128;
#pragma unroll
            for (int vb = 0; vb < 2; ++vb)
#pragma unroll
                for (int kb = 0; kb < 8; ++kb) { u32x2 w; w.x = pk2(acc[kb][vb][0], acc[kb][vb][1]); w.y = pk2(acc[kb][vb][2], acc[kb][vb][3]);
                    *(u32x2*)(out + (size_t)((c.wave * 2 + vb) * 16 + fr) * 128 + kb * 16 + 4 * g) = w; }
        }
        __syncthreads();
    }
}
__device__ __forceinline__ int wave_sum_dpp(int v) {
    v += __builtin_amdgcn_update_dpp(0, v, 0xB1, 0xf, 0xf, false);
    v += __builtin_amdgcn_update_dpp(0, v, 0x4E, 0xf, 0xf, false);
    v += __builtin_amdgcn_update_dpp(0, v, 0x141, 0xf, 0xf, false);
    v += __builtin_amdgcn_update_dpp(0, v, 0x140, 0xf, 0xf, false);
    v += __builtin_amdgcn_update_dpp(0, v, 0x142, 0xa, 0xf, false);
    v += __builtin_amdgcn_update_dpp(0, v, 0x143, 0xc, 0xf, false);
    return __builtin_amdgcn_readlane(v, 63);
}
#undef GLA_LOAD
template <int NE>
__device__ __forceinline__ unsigned dsa_select(const LAS unsigned* scq, int lane, int ch) {
    unsigned e[NE];
#pragma unroll
    for (int i = 0; i < NE; ++i) e[i] = (i <= ch) ? scq[64 * i + lane] : 0u;
    unsigned prefix = 0u; bool exact = false;
#pragma unroll 1
    for (int bit = 31; bit >= 0; --bit) {
        const unsigned cand = prefix | (1u << bit); int cv = 0, cs = 0;
#pragma unroll
        for (int i = 0; i < NE / 2; ++i) cv += (e[i] >= cand) ? 1 : 0;
#pragma unroll
        for (int i = NE / 2; i < NE; ++i) { cs += __popcll(__ballot(e[i] >= cand)); if ((i & 7) == 7) __builtin_amdgcn_sched_barrier(0); }
        const int cnt = wave_sum_dpp(cv) + cs;
        if (cnt >= 256) prefix = cand;
        if (cnt == 256) { exact = true; break; }
    }
    const unsigned T = prefix;
    unsigned selw = 0u;
#pragma unroll
    for (int i = 0; i < NE; ++i) selw |= (e[i] >= T) ? (1u << i) : 0u;
    if (!exact) {
        int cgt = 0, cge = 0;
#pragma unroll
        for (int i = 0; i < NE; ++i) { cgt += (e[i] > T) ? 1 : 0; cge += (e[i] >= T) ? 1 : 0; }
        cgt = wave_sum_dpp(cgt); cge = wave_sum_dpp(cge);
        if (cge != 256) {
            int quota = 256 - cgt; selw = 0u;
#pragma unroll 1
            for (int i = 0; i <= ch; ++i) { const unsigned v = scq[64 * i + lane];
                const u64 eq = __ballot(v == T); const int rank = __popcll(eq & ((1ull << lane) - 1ull));
                const bool take = (v > T) || (v == T && rank < quota);
                selw |= take ? (1u << i) : 0u; const int ne = __popcll(eq); quota = quota > ne ? quota - ne : 0; }
        }
    }
    return selw;
}
__device__ __forceinline__ unsigned ord_u32(float f) { f = f + 0.0f; const unsigned u = __float_as_uint(f); return (u & 0x80000000u) ? ~u : (u | 0x80000000u); }
__device__ __forceinline__ void dsa_index_job(const Ctx& c, const Args& a) {
    const us* proj = (const us*)(a.ws + WS_PROJ); unsigned* mask = (unsigned*)(a.ws + WS_MASK);
    LAS unsigned* sc = (LAS unsigned*)c.lds;
    const int fr = c.lane & 15, g = c.lane >> 4;
    for (int it0 = c.bid; it0 < 512; it0 += c.G) {
        const int b = it0 >> 7, qg = ((it0 / c.G) & 1) ? 127 - (it0 & 127) : (it0 & 127), ch = qg >> 2;
        const size_t tq0 = (size_t)b * SEQ + qg * 16;
        if (ch <= 3) {
            for (int i = c.tid; i < 16 * 64; i += 512) mask[tq0 * 64 + i] = (2u << ch) - 1u;
            continue;
        }
        {
            const us* qr = proj + (tq0 + fr) * DPROJ_P;
            bf16x8 iq[8][2]; float iw[8];
#pragma unroll
            for (int hh = 0; hh < 8; ++hh) { iq[hh][0] = ld8(qr + C_IQ + hh * 64 + 8 * g); iq[hh][1] = ld8(qr + C_IQ + hh * 64 + 32 + 8 * g); }
            { const bf16x8 w8 = ld8(qr + C_IW);
#pragma unroll
              for (int hh = 0; hh < 8; ++hh) iw[hh] = bf2f((us)w8[hh]); }
            const int nkb = 4 * (ch + 1);
#define DSA_LOADK(K0, K1, J0) _Pragma("unroll") for (int u = 0; u < 4; ++u) { const int kbx = c.wave + 8 * ((J0) + u), kb = kbx < nkb ? kbx : c.wave;          \
                    const us* kr = proj + ((size_t)b * SEQ + kb * 16 + fr) * DPROJ_P + C_IK; K0[u] = ld8(kr + 8 * g); K1[u] = ld8(kr + 32 + 8 * g); }
#define DSA_SCORE(K0, K1, J0) _Pragma("unroll") for (int u = 0; u < 4; ++u) { const int kb = c.wave + 8 * ((J0) + u); \
                    if (kb < nkb) { f32x4 s = (f32x4){0.f, 0.f, 0.f, 0.f}; \
                        _Pragma("unroll") for (int hh = 0; hh < 8; ++hh) { f32x4 d = mfma16(K0[u], iq[hh][0], (f32x4){0.f, 0.f, 0.f, 0.f}); d = mfma16(K1[u], iq[hh][1], d); \
                            _Pragma("unroll") for (int r = 0; r < 4; ++r) s[r] += iw[hh] * fmaxf(d[r], 0.f); } \
                        *(LAS u32x4*)(sc + fr * 2052 + kb * 16 + 4 * g) = (u32x4){ord_u32(s[0]), ord_u32(s[1]), ord_u32(s[2]), ord_u32(s[3])}; } }
            JREP(8) {
                bf16x8 a0[4], a1[4], b0[4], b1[4];
                const int ng = (nkb - c.wave + 31) >> 5;
                DSA_LOADK(a0, a1, 0)
                if (ng > 1) { DSA_LOADK(b0, b1, 4) }
                __builtin_amdgcn_sched_barrier(0);
                DSA_SCORE(a0, a1, 0)
                __builtin_amdgcn_sched_barrier(0);
                if (ng > 2) { DSA_LOADK(a0, a1, 8) }
                __builtin_amdgcn_sched_barrier(0);
                if (ng > 1) { DSA_SCORE(b0, b1, 4) }
                __builtin_amdgcn_sched_barrier(0);
                if (ng > 3) { DSA_LOADK(b0, b1, 12) }
                __builtin_amdgcn_sched_barrier(0);
                if (ng > 2) { DSA_SCORE(a0, a1, 8) }
                if (ng > 3) { DSA_SCORE(b0, b1, 12) }
            }
#undef DSA_LOADK
#undef DSA_SCORE
        }
        __syncthreads();
        JREP(9)
#pragma unroll 1
        for (int qq = 0; qq < 2; ++qq) {
            const int q = c.wave * 2 + qq; const LAS unsigned* scq = sc + q * 2052; unsigned selw;
            if (ch < 8) selw = dsa_select<8>(scq, c.lane, ch); else if (ch < 16) selw = dsa_select<16>(scq, c.lane, ch);
            else if (ch < 24) selw = dsa_select<24>(scq, c.lane, ch); else selw = dsa_select<32>(scq, c.lane, ch);
            mask[(tq0 + q) * 64 + c.lane] = selw;
        }
        __syncthreads();
    }
}

__device__ __forceinline__ void gla_scan_job(const Ctx& c, const Args& a) {
    const us* ckv = (const us*)(a.ws + WS_CKV); const float* dec = (const float*)(a.ws + WS_DEC); us* st = (us*)(a.ws + WS_ST);
    for (int idx = c.bid * 512 + c.tid; idx < 4 * 4 * 256 * 32; idx += c.G * 512) {
        const int k4 = idx & 31, v = (idx >> 5) & 255, h = (idx >> 13) & 3, b = idx >> 15;
        f32x4 s = (f32x4){0.f, 0.f, 0.f, 0.f};
#pragma unroll 1
        for (int n0 = 0; n0 < 32; n0 += 16) {
            f32x4 d[16], kv[16];
#pragma unroll
            for (int u = 0; u < 16; ++u) { const size_t it = (size_t)((b * 32 + n0 + u) * 4 + h);
                d[u] = *(const f32x4*)(dec + it * 128 + 4 * k4); const u32x2 kw = __builtin_nontemporal_load((const u32x2*)(ckv + (it * 256 + v) * 128 + 4 * k4));
                kv[u] = (f32x4){__uint_as_float(kw.x << 16), __uint_as_float(kw.x & 0xFFFF0000u), __uint_as_float(kw.y << 16), __uint_as_float(kw.y & 0xFFFF0000u)}; }
#pragma unroll
            for (int u = 0; u < 16; ++u) { const size_t it = (size_t)((b * 32 + n0 + u) * 4 + h);
                s = s * d[u] + kv[u];
                u32x2 w; w.x = pg8::cvt_pk_bf16(s[0], s[1]); w.y = pg8::cvt_pk_bf16(s[2], s[3]);
                *(u32x2*)(st + (it * 256 + v) * 128 + 4 * k4) = w; }
        }
    }
}
__device__ __forceinline__ void dsa_attn_job(const Ctx& c, const Args& a) {
    const us* proj = (const us*)(a.ws + WS_PROJ); const us* dvt = (const us*)(a.ws + WS_DVT); const unsigned* mask = (const unsigned*)(a.ws + WS_MASK);
    const int* pos = (const int*)a.in[I_POS]; us* mix = (us*)(a.ws + WS_MIX);
    const int fr = c.lane & 15, g = c.lane >> 4;
    for (int wi = c.bid * 8 + c.wave; wi < 2048; wi += c.G * 8) {
        const int b = wi >> 9, h = (wi >> 7) & 3, qg = wi & 127;
        const size_t tq = (size_t)b * SEQ + qg * 16 + fr;
        const us* qr = proj + tq * DPROJ_P + C_DQ + h * 128;
        bf16x8 qf[4];
#pragma unroll
        for (int ks = 0; ks < 4; ++ks) qf[ks] = ld8(qr + 32 * ks + 8 * g);
        const float slope = exp2f(-2.0f * (float)(h + 1)), scale = 0.08838834764831845f;
        const int pq = pos[tq];
        u32x4 mw[4];
#pragma unroll
        for (int kb = 0; kb < 4; ++kb) mw[kb] = *(const u32x4*)(mask + tq * 64 + kb * 16 + 4 * g);
        f32x4 o[8];
#pragma unroll
        for (int db = 0; db < 8; ++db) o[db] = (f32x4){0.f, 0.f, 0.f, 0.f};
        float m = -1e30f, l = 0.f;
        const int ch = qg >> 2;
        for (int jt = 0; jt <= ch; ++jt) {
            f32x4 s[4];
#pragma unroll
            for (int kb = 0; kb < 4; ++kb) {
                const size_t kt = (size_t)b * SEQ + jt * 64 + kb * 16;
                const us* kr = proj + (kt + fr) * DPROJ_P + C_DK;
                f32x4 d = (f32x4){0.f, 0.f, 0.f, 0.f};
#pragma unroll
                for (int ks = 0; ks < 4; ++ks) d = mfma16(ld8(kr + 32 * ks + 8 * g), qf[ks], d);
                const int4 pk = *(const int4*)(pos + kt + 4 * g);
                const int pkk[4] = {pk.x, pk.y, pk.z, pk.w};
#pragma unroll
                for (int r = 0; r < 4; ++r) { const int dd = pq - pkk[r]; const float dist = (float)(dd < 0 ? -dd : dd);
                    const bool sel = (mw[kb][r] >> jt) & 1u;
                    s[kb][r] = sel ? d[r] * scale - slope * dist : -1e30f; }
            }
            float mx = -1e30f;
#pragma unroll
            for (int kb = 0; kb < 4; ++kb)
#pragma unroll
                for (int r = 0; r < 4; ++r) mx = fmaxf(mx, s[kb][r]);
            mx = fmaxf(mx, __shfl_xor(mx, 16)); mx = fmaxf(mx, __shfl_xor(mx, 32));
            const float mn = fmaxf(m, mx), alpha = __expf(m - mn); m = mn;
            float ps = 0.f; f32x4 p[4];
#pragma unroll
            for (int kb = 0; kb < 4; ++kb)
#pragma unroll
                for (int r = 0; r < 4; ++r) { const float pv = (s[kb][r] > -1e29f) ? __expf(s[kb][r] - mn) : 0.f; p[kb][r] = pv; ps += pv; }
            l = l * alpha + ps;
#pragma unroll
            for (int db = 0; db < 8; ++db) o[db] *= alpha;
            bf16x8 pf[2];
#pragma unroll
            for (int u = 0; u < 2; ++u) { const unsigned w0 = pk2(p[2 * u][0], p[2 * u][1]), w1 = pk2(p[2 * u][2], p[2 * u][3]), w2 = pk2(p[2 * u + 1][0], p[2 * u + 1][1]), w3 = pk2(p[2 * u + 1][2], p[2 * u + 1][3]);
                const u32x4 ww = (u32x4){w0, w1, w2, w3}; pf[u] = *(const bf16x8*)&ww; }
#pragma unroll
            for (int db = 0; db < 8; ++db) {
                const us* vr = dvt + ((size_t)b * 128 + db * 16 + fr) * SEQ + jt * 64 + 4 * g;
#pragma unroll
                for (int u = 0; u < 2; ++u) { const u32x2 lo = *(const u32x2*)(vr + 32 * u), hi = *(const u32x2*)(vr + 32 * u + 16);
                    const u32x4 vv = (u32x4){lo.x, lo.y, hi.x, hi.y};
                    o[db] = mfma16(*(const bf16x8*)&vv, pf[u], o[db]); }
            }
        }
        l += __shfl_xor(l, 16); l += __shfl_xor(l, 32);
        const float inv = 1.0f / l;
        us* op = mix + tq * D + 1536 + h * 128 + 4 * g;
#pragma unroll
        for (int db = 0; db < 8; ++db) { u32x2 w; w.x = pk2(o[db][0] * inv, o[db][1] * inv); w.y = pk2(o[db][2] * inv, o[db][3] * inv); *(u32x2*)(op + db * 16) = w; }
    }
}


template <bool DSA>
__device__ __forceinline__ void attn_tiled_job(const Ctx& c, const Args& a, int first_block, int nblocks) {
    constexpr int DQK = DSA ? 128 : 192, KBYTES = (DQK / 8) * 1024  , RSV = 144, POSOFF = KBYTES + 128 * RSV, BUF = POSOFF + 256, NKS = DQK / 32;
    const us* proj = (const us*)(a.ws + WS_PROJ);
    const us* Q = DSA ? proj : (const us*)(a.ws + WS_Q); const us* KN = (const us*)(a.ws + WS_KN); const us* KPE = (const us*)(a.ws + WS_KPE);
    const us* VT = DSA ? (const us*)(a.ws + WS_DVT) : (const us*)(a.ws + WS_VT);
    const unsigned* mask = (const unsigned*)(a.ws + WS_MASK); const int* pos = (const int*)a.in[I_POS]; us* mix = (us*)(a.ws + WS_MIX);
    const int fr = c.lane & 15, g = c.lane >> 4, w = c.wave;
    const int krow = (c.tid & 15) | (((c.tid >> 6) & 3) << 4), krc = ((c.tid >> 4) & 3) | (((c.tid >> 8) & 1) << 2);
    const int vb = c.bid - first_block; if (vb < 0 || vb >= nblocks) return;
    for (int pv = vb; pv < 128; pv += nblocks) {
        const int pi = (nblocks == 128 && (first_block & 7) == 0) ? (pv & 7) * 16 + (pv >> 3) : pv;
#pragma unroll 1
        for (int half = 0; half < 2; ++half) {
            int b, h, q0, ntiles, mych;
            if (DSA) { b = pi >> 5; const int jj = pi & 31, qb = half == 0 ? 63 - jj : jj; q0 = qb * 32; h = w & 3; mych = q0 >> 6; ntiles = mych + 1; }
            else { b = pi >> 5; h = (pi >> 3) & 3; const int jj = pi & 7, qb = half == 0 ? 15 - jj : jj; q0 = qb * 128; mych = (q0 + 16 * w) >> 6; ntiles = ((q0 + 127) >> 6) + 1; }
            const int qoff = DSA ? 16 * (w >> 2) : 16 * w;
            const size_t tq = (size_t)b * SEQ + q0 + qoff + fr;
            bf16x8 qf[NKS];
            { const us* qr = DSA ? proj + tq * DPROJ_P + C_DQ + h * 128 : Q + tq * 768 + h * 192;
#pragma unroll
              for (int ks = 0; ks < NKS; ++ks) qf[ks] = ld8(qr + 32 * ks + 8 * g); }
            const float scale = (DSA ? 0.08838834764831845f : 0.07216878364870322f) * 1.4426950408889634f;
            float slope = 0.f, pq = 0.f; u32x4 mw[4];
            if (DSA) { slope = exp2f(-2.0f * (float)(h + 1)) * 1.4426950408889634f; pq = (float)pos[tq];
#pragma unroll
                for (int kb = 0; kb < 4; ++kb) mw[kb] = *(const u32x4*)(mask + tq * 64 + kb * 16 + 4 * g); }
            f32x4 o[8];
#pragma unroll
            for (int db = 0; db < 8; ++db) o[db] = (f32x4){0.f, 0.f, 0.f, 0.f};
            float m = -1e30f, l = 0.f;
            u32x4 st[5]; f32x4 stp = (f32x4){0.f, 0.f, 0.f, 0.f};
            const size_t tokb = (size_t)b * SEQ;
#define ATT_LOAD(jt) do { const size_t k0 = tokb + (size_t)(jt) * 64; \
                _Pragma("unroll") for (int i = 0; i < 2; ++i) { const int c16 = krc + 8 * i; \
                    st[i] = DSA ? *(const u32x4*)(proj + (k0 + krow) * DPROJ_P + C_DK + c16 * 8) : *(const u32x4*)(KN + (k0 + krow) * 512 + h * 128 + c16 * 8); } \
                if (!DSA) { st[4] = *(const u32x4*)(KPE + (k0 + krow) * 64 + krc * 8); } \
                if (DSA && c.tid < 16) { const i32x4 pi_ = *(const i32x4*)(pos + k0 + 4 * c.tid); stp = (f32x4){(float)pi_[0], (float)pi_[1], (float)pi_[2], (float)pi_[3]}; } \
                _Pragma("unroll") for (int i = 0; i < 2; ++i) { const int id = c.tid + 512 * i, d = id >> 3, c16 = id & 7; \
                    st[2 + i] = DSA ? *(const u32x4*)(VT + ((size_t)b * 128 + d) * SEQ + (size_t)(jt) * 64 + c16 * 8) : *(const u32x4*)(VT + (size_t)(h * 128 + d) * NTOK + k0 + c16 * 8); } } while (0)
#define ATT_STORE(buf) do { LAS unsigned char* bp = c.lds + (buf) * BUF; \
                _Pragma("unroll") for (int i = 0; i < 2; ++i) *(LAS u32x4*)(bp + (krc + 8 * i) * 1024 + krow * 16) = st[i]; \
                if (!DSA) *(LAS u32x4*)(bp + (16 + krc) * 1024 + krow * 16) = st[4]; \
                if (DSA && c.tid < 16) *(LAS f32x4*)(bp + POSOFF + 16 * c.tid) = stp; \
                _Pragma("unroll") for (int i = 0; i < 2; ++i) { const int id = c.tid + 512 * i, d = id >> 3, c16 = id & 7; *(LAS u32x4*)(bp + KBYTES + d * RSV + c16 * 16) = st[2 + i]; } } while (0)
            ATT_LOAD(0); ATT_STORE(0);
            __syncthreads();
#pragma unroll 1
            for (int jt = 0; jt < ntiles; ++jt) {
                const bool more = jt + 1 < ntiles;
                if (more) ATT_LOAD(jt + 1);
                if (jt <= mych) {
                    const LAS unsigned char* bp = c.lds + (jt & 1) * BUF;
                    f32x4 s[4];
                    bf16x8 kfa[2][NKS], kfb[2][NKS]; f32x4 dq[4];
#define ATT_KRD(KF, KH) _Pragma("unroll") for (int k2 = 0; k2 < 2; ++k2) _Pragma("unroll") for (int ks = 0; ks < NKS; ++ks) \
                        KF[k2][ks] = *(const LAS bf16x8*)(bp + (4 * ks + g) * 1024 + ((2 * (KH) + k2) * 16 + fr) * 16)
#define ATT_QK(KF, KH) _Pragma("unroll") for (int k2 = 0; k2 < 2; ++k2) { f32x4 d = (f32x4){0.f, 0.f, 0.f, 0.f}; \
                        _Pragma("unroll") for (int ks = 0; ks < NKS; ++ks) d = mfma16(KF[k2][ks], qf[ks], d); dq[2 * (KH) + k2] = d; }
#define ATT_SC(KB) do { const f32x4 d = dq[KB]; \
                        if (DSA) { const f32x4 pk = *(const LAS f32x4*)(bp + POSOFF + ((KB) * 16 + 4 * g) * 4); \
                            _Pragma("unroll") for (int r = 0; r < 4; ++r) { const float sv = fmaf(-slope, fabsf(pq - pk[r]), d[r] * scale); \
                                s[KB][r] = ((mw[KB][r] >> jt) & 1u) ? sv : -__builtin_inff(); } \
                        } else s[KB] = d * scale; } while (0)
                    ATT_KRD(kfa, 0);
                    __builtin_amdgcn_sched_barrier(0);
                    ATT_QK(kfa, 0)
                    ATT_KRD(kfb, 1);
                    __builtin_amdgcn_sched_barrier(0);
                    ATT_SC(0); ATT_SC(1);
                    ATT_QK(kfb, 1)
                    ATT_SC(2); ATT_SC(3);
#undef ATT_KRD
#undef ATT_QK
#undef ATT_SC
                    u32x2 vq[5][4];
#define ATT_VRD(db_) do { const LAS unsigned char* vr_ = bp + KBYTES + ((db_) * 16 + fr) * RSV + 8 * g; \
                        vq[(db_) % 5][0] = *(const volatile LAS u32x2*)(vr_); vq[(db_) % 5][1] = *(const volatile LAS u32x2*)(vr_ + 32); \
                        vq[(db_) % 5][2] = *(const volatile LAS u32x2*)(vr_ + 64); vq[(db_) % 5][3] = *(const volatile LAS u32x2*)(vr_ + 96); } while (0)
                    ATT_VRD(0); ATT_VRD(1); ATT_VRD(2); ATT_VRD(3);
                    float mx = -1e30f;
#pragma unroll
                    for (int kb = 0; kb < 4; ++kb)
#pragma unroll
                        for (int r = 0; r < 4; ++r) mx = fmaxf(mx, s[kb][r]);
                    mx = rows_max(mx);
                    const float mn = fmaxf(m, mx), alpha = __builtin_amdgcn_exp2f(m - mn); m = mn;
                    float ps = 0.f; f32x4 p[4];
#pragma unroll
                    for (int kb = 0; kb < 4; ++kb)
#pragma unroll
                        for (int r = 0; r < 4; ++r) { const float pv = __builtin_amdgcn_exp2f(s[kb][r] - mn); p[kb][r] = pv; ps += pv; }
                    if (__ballot(alpha != 1.0f) != 0ull) {
                        l *= alpha;
#pragma unroll
                        for (int db = 0; db < 8; ++db) o[db] *= alpha;
                    }
                    l += ps;
                    bf16x8 pf[2];
#pragma unroll
                    for (int u = 0; u < 2; ++u) { const u32x4 ww = (u32x4){pg8::cvt_pk_bf16_t(p[2 * u][0], p[2 * u][1]), pg8::cvt_pk_bf16_t(p[2 * u][2], p[2 * u][3]), pg8::cvt_pk_bf16_t(p[2 * u + 1][0], p[2 * u + 1][1]), pg8::cvt_pk_bf16_t(p[2 * u + 1][2], p[2 * u + 1][3])};
                        pf[u] = *(const bf16x8*)&ww; }
#pragma unroll
                    for (int db = 0; db < 8; ++db) {
                        if (db + 4 < 8) ATT_VRD(db + 4);
#pragma unroll
                        for (int u = 0; u < 2; ++u) { const u32x2 lo = vq[db % 5][2 * u], hi = vq[db % 5][2 * u + 1];
                            const u32x4 vv = (u32x4){lo.x, lo.y, hi.x, hi.y};
                            o[db] = mfma16(*(const bf16x8*)&vv, pf[u], o[db]); }
                    }
#undef ATT_VRD
                }
                if (more) ATT_STORE((jt + 1) & 1);
                __syncthreads();
            }
#undef ATT_LOAD
#undef ATT_STORE
            l = rows_sum(l);
            const float inv = 1.0f / l;
            unsigned char* op = (unsigned char*)mix + tq * D + (DSA ? 1536 : 0) + h * 128 + 4 * g;
#pragma unroll
            for (int db = 0; db < 8; ++db) *(unsigned*)(op + db * 16) = pk4_fp8(o[db][0] * inv, o[db][1] * inv, o[db][2] * inv, o[db][3] * inv);
        }
    }
}

__device__ __forceinline__ void mla_attn_job(const Ctx& c, const Args& a) {
    const us* Q = (const us*)(a.ws + WS_Q); const us* KN = (const us*)(a.ws + WS_KN); const us* KPE = (const us*)(a.ws + WS_KPE); const us* VT = (const us*)(a.ws + WS_VT);
    us* mix = (us*)(a.ws + WS_MIX);
    const int fr = c.lane & 15, g = c.lane >> 4;
    for (int wi = c.bid * 8 + c.wave; wi < 2048; wi += c.G * 8) {
        const int b = wi >> 9, h = (wi >> 7) & 3, qg = wi & 127;
        const size_t tq = (size_t)b * SEQ + qg * 16 + fr;
        const us* qr = Q + tq * 768 + h * 192;
        bf16x8 qf[6];
#pragma unroll
        for (int ks = 0; ks < 6; ++ks) qf[ks] = ld8(qr + 32 * ks + 8 * g);
        const float scale = 0.07216878364870322f;
        f32x4 o[8];
#pragma unroll
        for (int db = 0; db < 8; ++db) o[db] = (f32x4){0.f, 0.f, 0.f, 0.f};
        float m = -1e30f, l = 0.f;
        const int ch = qg >> 2;
        for (int jt = 0; jt <= ch; ++jt) {
            f32x4 s[4];
#pragma unroll
            for (int kb = 0; kb < 4; ++kb) {
                const size_t kt = (size_t)b * SEQ + jt * 64 + kb * 16 + fr;
                const us* kr = KN + kt * 512 + h * 128; const us* pr = KPE + kt * 64;
                f32x4 d = (f32x4){0.f, 0.f, 0.f, 0.f};
#pragma unroll
                for (int ks = 0; ks < 4; ++ks) d = mfma16(ld8(kr + 32 * ks + 8 * g), qf[ks], d);
#pragma unroll
                for (int ks = 0; ks < 2; ++ks) d = mfma16(ld8(pr + 32 * ks + 8 * g), qf[4 + ks], d);
                s[kb] = d * scale;
            }
            float mx = -1e30f;
#pragma unroll
            for (int kb = 0; kb < 4; ++kb)
#pragma unroll
                for (int r = 0; r < 4; ++r) mx = fmaxf(mx, s[kb][r]);
            mx = fmaxf(mx, __shfl_xor(mx, 16)); mx = fmaxf(mx, __shfl_xor(mx, 32));
            const float mn = fmaxf(m, mx), alpha = __expf(m - mn); m = mn;
            float ps = 0.f; f32x4 p[4];
#pragma unroll
            for (int kb = 0; kb < 4; ++kb)
#pragma unroll
                for (int r = 0; r < 4; ++r) { const float pv = __expf(s[kb][r] - mn); p[kb][r] = pv; ps += pv; }
            l = l * alpha + ps;
#pragma unroll
            for (int db = 0; db < 8; ++db) o[db] *= alpha;
            bf16x8 pf[2];
#pragma unroll
            for (int u = 0; u < 2; ++u) { const unsigned w0 = pk2(p[2 * u][0], p[2 * u][1]), w1 = pk2(p[2 * u][2], p[2 * u][3]), w2 = pk2(p[2 * u + 1][0], p[2 * u + 1][1]), w3 = pk2(p[2 * u + 1][2], p[2 * u + 1][3]);
                const u32x4 ww = (u32x4){w0, w1, w2, w3}; pf[u] = *(const bf16x8*)&ww; }
#pragma unroll
            for (int db = 0; db < 8; ++db) {
                const us* vr = VT + (size_t)(h * 128 + db * 16 + fr) * NTOK + (size_t)b * SEQ + jt * 64 + 4 * g;
#pragma unroll
                for (int u = 0; u < 2; ++u) { const u32x2 lo = *(const u32x2*)(vr + 32 * u), hi = *(const u32x2*)(vr + 32 * u + 16);
                    const u32x4 vv = (u32x4){lo.x, lo.y, hi.x, hi.y};
                    o[db] = mfma16(*(const bf16x8*)&vv, pf[u], o[db]); }
            }
        }
        l += __shfl_xor(l, 16); l += __shfl_xor(l, 32);
        const float inv = 1.0f / l;
        us* op = mix + tq * D + h * 128 + 4 * g;
#pragma unroll
        for (int db = 0; db < 8; ++db) { u32x2 w; w.x = pk2(o[db][0] * inv, o[db][1] * inv); w.y = pk2(o[db][2] * inv, o[db][3] * inv); *(u32x2*)(op + db * 16) = w; }
    }
}
__device__ __forceinline__ void gla_out_job(const Ctx& c, const Args& a, int l) {
    const us* proj = (const us*)(a.ws + WS_PROJ); const us* st = (const us*)(a.ws + WS_ST); us* mix = (us*)(a.ws + WS_MIX);
    const float* gn = a.in[I_GNG] + l * 256;
    const int fr = c.lane & 15, g = c.lane >> 4, w = c.wave, is = w >> 2, wq = w & 3;
    for (int ip = c.bid; ip < 256; ip += c.G) {
        const int item = 2 * ip + is; const int b = item >> 7, n = (item >> 2) & 31, h = item & 3;
        const us* sp = st + (size_t)item * 256 * 128;
        u32x4 sv[16];
#pragma unroll
        for (int u = 0; u < 16; ++u) { const int v = (c.tid & 15) | (wq << 4) | ((u & 3) << 6), ch = ((c.tid >> 4) & 3) | ((u >> 2) << 2); sv[u] = *(const u32x4*)(sp + (size_t)v * 128 + ch * 8); }
        const size_t tq = (size_t)b * SEQ + n * 64 + wq * 16 + fr;
        const us* qr = proj + tq * DPROJ_P + C_GQ + h * 128;
        bf16x8 qf[4];
#pragma unroll
        for (int ks = 0; ks < 4; ++ks) qf[ks] = ld8(qr + 32 * ks + 8 * g);
        const us* rr = proj + tq * DPROJ_P + C_GR + h * 256 + 64 * g; unsigned char* op = (unsigned char*)mix + tq * D + 512 + h * 256 + 64 * g;
        u32x4 rw[8];
#pragma unroll
        for (int j = 0; j < 8; ++j) rw[j] = *(const u32x4*)(rr + 8 * j);
        LAS unsigned char* lb = c.lds + is * 65536;
#pragma unroll
        for (int u = 0; u < 16; ++u) { const int v = (c.tid & 15) | (wq << 4) | ((u & 3) << 6), ch = ((c.tid >> 4) & 3) | ((u >> 2) << 2);
            const int p = (v & 3) + 4 * ((v >> 6) & 3) + 16 * ((v >> 2) & 15); *(LAS u32x4*)(lb + ch * 4096 + p * 16) = sv[u]; }
        __syncthreads();
        f32x4 acc[16]; float ss = 0.f;
#pragma unroll
        for (int vb = 0; vb < 16; ++vb) { f32x4 d = (f32x4){0.f, 0.f, 0.f, 0.f};
#pragma unroll
            for (int ks = 0; ks < 4; ++ks) d = mfma16(*(const LAS bf16x8*)(lb + (4 * ks + g) * 4096 + (vb * 16 + fr) * 16), qf[ks], d);
            d *= 0.08838834764831845f; acc[vb] = d; ss += d[0] * d[0] + d[1] * d[1] + d[2] * d[2] + d[3] * d[3]; }
        ss = rows_sum(ss);
        const float rstd = rsqrtf(ss * (1.0f / 256.0f) + EPS);
#pragma unroll
        for (int j = 0; j < 4; ++j) {
            unsigned ow[4];
#pragma unroll
            for (int q = 0; q < 4; ++q) { const int vb = 4 * j + q; const f32x4 gv = *(const f32x4*)(gn + 64 * g + 4 * vb);
                const u32x4 rq = rw[2 * j + (q >> 1)]; const unsigned r01 = (q & 1) ? rq.z : rq.x, r23 = (q & 1) ? rq.w : rq.y;
                const float r0 = __uint_as_float(r01 << 16), r1 = __uint_as_float(r01 & 0xFFFF0000u), r2 = __uint_as_float(r23 << 16), r3 = __uint_as_float(r23 & 0xFFFF0000u);
                ow[q] = pk4_fp8(acc[vb][0] * rstd * gv[0] * siluf(r0), acc[vb][1] * rstd * gv[1] * siluf(r1), acc[vb][2] * rstd * gv[2] * siluf(r2), acc[vb][3] * rstd * gv[3] * siluf(r3)); }
            *(u32x4*)(op + 16 * j) = (u32x4){ow[0], ow[1], ow[2], ow[3]};
            __builtin_amdgcn_sched_barrier(0);
        }
        __syncthreads();
    }
}

__device__ __forceinline__ void moe_assign_phase(const Ctx& c, const Args& a) {
    const int* rt = (const int*)(a.ws + WS_ROUTE); int* slot = (int*)(a.ws + WS_ROUTE) + 4 * NTOK; int* ctl = (int*)(a.ws + WS_MOECTL);
    int* s2t = (int*)(a.ws + WS_XG);
    LAS int* cnt = (LAS int*)c.lds;
    const int TPB = NTOK / 256;
    for (int vb = c.bid; vb < 256; vb += c.G) {
        if (c.tid < 32) cnt[c.tid] = 0;
        __syncthreads();
        const int t0 = vb * TPB;
        {
            int e0v[16], e1v[16];
#pragma unroll
            for (int u = 0; u < 16; ++u) { e0v[u] = rt[c.tid + 512 * u]; e1v[u] = rt[NTOK + c.tid + 512 * u]; }
            int la[8], lb[8];
#pragma unroll
            for (int e = 0; e < 8; ++e) { la[e] = 0; lb[e] = 0; }
#pragma unroll
            for (int u = 0; u < 16; ++u) { const bool bef = (c.tid + 512 * u) < t0;
#pragma unroll
                for (int e = 0; e < 8; ++e) { const int hit = (e0v[u] == e) + (e1v[u] == e); la[e] += hit; lb[e] += bef ? hit : 0; } }
#pragma unroll
            for (int e = 0; e < 8; ++e) { const int sa = wave_sum_dpp(la[e]), sb = wave_sum_dpp(lb[e]);
                if (c.lane == 0) { atomicAdd((int*)&cnt[e], sa); atomicAdd((int*)&cnt[8 + e], sb); } }
        }
        __syncthreads();
        if (c.tid < 32) {
            int start = 0, st[8], tl[8];
#pragma unroll
            for (int e = 0; e < 8; ++e) { const int tiles = (cnt[e] + 255) >> 8; st[e] = start; tl[e] = tiles; start += tiles * 256; }
            const int t = t0 + c.tid, e0 = rt[t], e1 = rt[NTOK + t];
            int s0 = 0, s1 = 0;
#pragma unroll
            for (int e = 0; e < 8; ++e) { const u64 m = __ballot(e0 == e || e1 == e); const int rank = __popcll(m & ((1ull << c.tid) - 1ull)), base = st[e] + cnt[8 + e];
                if (e0 == e) s0 = base + rank; if (e1 == e) s1 = base + rank; }
            cnt[32 + 2 * c.tid] = s0; cnt[33 + 2 * c.tid] = s1; slot[t] = s0; slot[NTOK + t] = s1;
            if (c.tid < 8) { cnt[16 + c.tid] = st[c.tid]; cnt[24 + c.tid] = tl[c.tid]; }
            if (vb == 0 && c.tid == 0) { int T = 0;
#pragma unroll
                for (int e = 0; e < 8; ++e) { for (int k = 0; k < tl[e]; ++k) ctl[16 + T + k] = e; T += tl[e]; ctl[128 + e] = cnt[e]; } ctl[0] = T; }
        }
        __syncthreads();
        if (c.tid < 64) s2t[cnt[32 + c.tid]] = t0 + (c.tid >> 1);
        { const int e = vb & 7, first = cnt[16 + e] + cnt[e], end = cnt[16 + e] + cnt[24 + e] * 256;
          for (int r = first + (vb >> 3) + 32 * c.tid; r < end; r += 32 * 512) s2t[r] = 0; }
        __syncthreads();
    }
}

__device__ __forceinline__ void final_phase(const Ctx& c, const Args& a) {
    const int* rt = (const int*)(a.ws + WS_ROUTE); const us* y = (const us*)(a.ws + WS_Y);
    const float* g2 = (const float*)(a.ws + WS_MOD) + (size_t)1 * 4 * 12288 + 10240; const float* fg = a.in[I_FNG];
    for (int rg = c.bid * 8 + c.wave; rg < NTOK / 4; rg += c.G * 8) {
        const int row0 = rg * 4, b = row0 >> 11;
        f32x4 xv[8], xn[8]; u32x2 ya[8], yb[8], yan[8], ybn[8];
        { const int s0 = rt[4 * NTOK + row0], s1 = rt[5 * NTOK + row0];
#pragma unroll
          for (int i = 0; i < 8; ++i) { const int col = (i * 64 + c.lane) * 4; xv[i] = ldx4<true>((const float*)(a.ws + WS_XB), (size_t)row0 * D + col); ya[i] = *(const u32x2*)(y + (size_t)s0 * D + col); yb[i] = *(const u32x2*)(y + (size_t)s1 * D + col); } }
#pragma unroll 1
        for (int k = 0; k < 4; ++k) {
            const int row = row0 + k; const float w0 = ((const float*)rt)[2 * NTOK + row], w1 = ((const float*)rt)[3 * NTOK + row];
            if (k < 3) { const int s0 = rt[4 * NTOK + row + 1], s1 = rt[5 * NTOK + row + 1];
#pragma unroll
                for (int i = 0; i < 8; ++i) { const int col = (i * 64 + c.lane) * 4; xn[i] = ldx4<true>((const float*)(a.ws + WS_XB), (size_t)(row + 1) * D + col); yan[i] = *(const u32x2*)(y + (size_t)s0 * D + col); ybn[i] = *(const u32x2*)(y + (size_t)s1 * D + col); } }
            f32x4 v[8]; float ss = 0.f;
#pragma unroll
            for (int i = 0; i < 8; ++i) {
                const f32x4 y0 = (f32x4){__uint_as_float(ya[i].x << 16), __uint_as_float(ya[i].x & 0xFFFF0000u), __uint_as_float(ya[i].y << 16), __uint_as_float(ya[i].y & 0xFFFF0000u)};
                const f32x4 y1 = (f32x4){__uint_as_float(yb[i].x << 16), __uint_as_float(yb[i].x & 0xFFFF0000u), __uint_as_float(yb[i].y << 16), __uint_as_float(yb[i].y & 0xFFFF0000u)};
                v[i] = xv[i] + *(const f32x4*)(g2 + (size_t)b * 12288 + (i * 64 + c.lane) * 4) * (y0 * w0 + y1 * w1);
                ss += v[i][0] * v[i][0] + v[i][1] * v[i][1] + v[i][2] * v[i][2] + v[i][3] * v[i][3]; }
            ss = wave_sum(ss);
            const float rstd = rsqrtf(ss * (1.0f / D) + EPS);
#pragma unroll
            for (int i = 0; i < 8; ++i) { const int col = (i * 64 + c.lane) * 4; *(f32x4*)(a.out + (size_t)row * D + col) = v[i] * rstd * *(const f32x4*)(fg + col); }
            if (k < 3) {
#pragma unroll
                for (int i = 0; i < 8; ++i) { xv[i] = xn[i]; ya[i] = yan[i]; yb[i] = ybn[i]; } }
        }
    }
}

constexpr int NPHASE = 24;
#ifndef PH_MASK
#define PH_MASK 0xFFFFFFu
#endif
#ifndef REP_MASK
#define REP_MASK 0x0u
#endif
#define IN(k) ((((PH_MASK) >> (k)) & 1u) && a.lo <= (k) && (k) < a.hi)
#define REP(k) _Pragma("unroll") for (int rep_ = 0; rep_ < 1 + (int)(((REP_MASK) >> (k)) & 1u); (++rep_ < 1 + (int)(((REP_MASK) >> (k)) & 1u)) ? xcd_barrier(bar) : (void)0)
#ifndef BAR_REPS
#define BAR_REPS 1
#endif
#define SEAM(k) do { if (a.lo <= (k) && (k) + 1 < a.hi) { _Pragma("unroll") for (int br_ = 0; br_ < BAR_REPS; ++br_) xcd_barrier(bar); } } while (0)

template <int l>
__device__ __forceinline__ void layer_phases(const Ctx& c, const Args& a, const XcdBarrier& bar) {
    constexpr int P = 1 + 11 * l;
    unsigned char* ws = a.ws;
    const float* modl = (const float*)(ws + WS_MOD) + (size_t)l * 4 * 12288;
    const float* xcur = (l == 0) ? a.in[I_X] : (const float*)(ws + WS_XB);
    const bool fuse_norms = (c.G == 256);
    if (!(l == 1 && fuse_norms) && !(l == 0 && IN(0) && IN(1))) {
        if (IN(P + 0)) REP(P + 0) norm_phase<false, 2, (l == 1)>(c, a, xcur, a.in[I_N1G] + l * D, modl, 0, 2048, (us*)(ws + WS_H), ws + WS_H8);
        SEAM(P + 0);
    }
    if (IN(P + 1)) REP(P + 1) {
        const bool deal3 = (c.G == 256);
        {
            pg8::Gemm g{D, D, D}; pg8::DenseSched S; S.init(ws + WS_H, (us*)(ws + WS_WIN) + (size_t)l * (DPROJ_P - NP8) * D, D, D, NTOK, DPROJ_P - NP8, c.G, c.bid);
            pg8::EpiBf16 E{(us*)(ws + WS_PROJ) + NP8, DPROJ_P, 0};
            pg8::gemm_phase<pg8::EpiBf16, pg8::DenseSched, true, true>(c.lds, g, S, E);
        }
        {
            pg8::Gemm g{D / 2, D / 2, D / 2}; pg8::DenseSched S;
            if (!deal3) S.init(ws + WS_H8, ws + WS_WIN8 + (size_t)l * NP8 * D, D / 2, D / 2, NTOK, NP8, c.G, c.bid);
            else if (c.bid < 96) S.init(ws + WS_H8, ws + WS_WIN8 + (size_t)l * NP8 * D, D / 2, D / 2, NTOK, NP8, 96, c.bid, 0, 96);
            else S.init(ws + WS_H8, ws + WS_WIN8 + (size_t)l * NP8 * D, D / 2, D / 2, NTOK, NP8, 160, c.bid - 96, 96);
            pg8::EpiBf16 E{(us*)(ws + WS_PROJ), DPROJ_P, 0};
            pg8::gemm_phase<pg8::EpiBf16, pg8::DenseSched, true, true, true>(c.lds, g, S, E);
        }
    }
    SEAM(P + 1);
    if (IN(P + 2)) REP(P + 2) {
#ifndef SKIP_J0
        JREP(0) { rowstats_job(c, a); dvt_job(c, a); }
#endif
#ifndef SKIP_J1
        JREP(1) gla_a_job(c, a, l);
#endif
#ifndef SKIP_J2
        JREP(2) dsa_index_job(c, a);
#endif
    }
    SEAM(P + 2);
    if (IN(P + 3)) REP(P + 3) {
        const float* rs = (const float*)(ws + WS_RSTD);
#ifndef SKIP_J3
        {
            pg8::Gemm g{DPROJ_P, 512, 512}; pg8::DenseSched S; S.init((const us*)(ws + WS_PROJ) + C_CQ, (us*)(ws + WS_WUQ) + (size_t)l * 768 * 512, DPROJ_P, 512, NTOK, 768, c.G, c.bid);
            pg8::EpiQRope E{(us*)(ws + WS_Q), rs, (const float*)(ws + WS_CS)};
            pg8::gemm_phase<pg8::EpiQRope, pg8::DenseSched, false, true>(c.lds, g, S, E);
        }
#endif
#ifndef SKIP_J4
#ifndef SKIP_J4A
        {
            pg8::Gemm g{DPROJ_P, 256, 256}; pg8::DenseSched S; S.init((const us*)(ws + WS_PROJ) + C_CKV, (us*)(ws + WS_WUKV) + (size_t)l * 1024 * 256, DPROJ_P, 256, NTOK, 512, c.G, (c.bid + c.G - 96 % c.G) % c.G);
            pg8::EpiScaleRow E{(us*)(ws + WS_KN), 512, rs + NTOK};
            pg8::gemm_phase<pg8::EpiScaleRow, pg8::DenseSched, false, true>(c.lds, g, S, E);
        }
#endif
#ifndef SKIP_J4B
        {
            pg8::Gemm g{256, DPROJ_P, 256}; pg8::DenseSched S; S.init((us*)(ws + WS_WUKV) + (size_t)l * 1024 * 256 + (size_t)512 * 256, (const us*)(ws + WS_PROJ) + C_CKV, 256, DPROJ_P, 512, NTOK, c.G, (c.bid + c.G - 160 % c.G) % c.G);
            pg8::EpiScaleCol E{(us*)(ws + WS_VT), NTOK, rs + NTOK};
            pg8::gemm_phase<pg8::EpiScaleCol, pg8::DenseSched, false, true>(c.lds, g, S, E);
        }
#endif
#endif
#ifndef SKIP_J5
        JREP(5) gla_scan_job(c, a);
#endif
    }
    SEAM(P + 3);
    if (IN(P + 4)) REP(P + 4) {
        const int hg = c.G >> 1;
        JREP(6) { if (c.bid < hg) attn_tiled_job<false>(c, a, 0, hg); else attn_tiled_job<true>(c, a, hg, c.G - hg); }
        JEXTRA(10) { if (c.bid < hg) attn_tiled_job<false>(c, a, 0, hg); }
        JEXTRA(11) { if (c.bid >= hg) attn_tiled_job<true>(c, a, hg, c.G - hg); }
        JREP(7) gla_out_job(c, a, l);
    }
    SEAM(P + 4);
    if (IN(P + 5)) REP((l == 0) ? P + 5 : 31) {
        pg8::Gemm g{D / 2, D / 2, D / 2}; pg8::DenseSched S; S.init(ws + WS_MIX, ws + WS_WOUT + (size_t)l * D * D, D / 2, D / 2, NTOK, D, c.G, c.bid);
        if (l == 0 && fuse_norms) {
            pg8::EpiResidNorm<true, false> E{a.in[I_X], (us*)(ws + WS_XB), modl + 4096, 12288, a.in[I_N2G], modl, 6144, 8192, ws + WS_H, nullptr,
                                             (unsigned*)(ws + WS_NSLOT), (unsigned*)(ws + WS_NCNT), (unsigned*)(ws + WS_BAR) + XB_TMO};
            pg8::gemm_phase<pg8::EpiResidNorm<true, false>, pg8::DenseSched, false, true, true>(c.lds, g, S, E);
        } else {
            pg8::EpiResid<(l == 0)> E{a.in[I_X], (us*)(ws + WS_XB), modl + 4096, 12288};
            pg8::gemm_phase<pg8::EpiResid<(l == 0)>, pg8::DenseSched, false, true, true>(c.lds, g, S, E);
        }
    }
    SEAM(P + 5);
    if (!(l == 0 && fuse_norms)) {
        if (IN(P + 6)) REP(P + 6) norm_phase<(l == 1), 1, true>(c, a, (const float*)(ws + WS_XB), a.in[I_N2G] + l * D, modl, 6144, 8192, (us*)(ws + WS_H));
        SEAM(P + 6);
    }
    if constexpr (l == 0) {
        if (IN(P + 8)) REP(P + 8) {
            pg8::Gemm g{D / 2, D / 2, D / 2}; pg8::DenseSched S; S.init(ws + WS_H, ws + WS_WGU, D / 2, D / 2, NTOK, 2 * DFF, c.G, c.bid);
            pg8::EpiSwiglu<true> E{(us*)(ws + WS_ACT), DFF, nullptr, 0ull, 0u};
            pg8::gemm_phase<pg8::EpiSwiglu<true>, pg8::DenseSched, true, true, true>(c.lds, g, S, E);
            if (c.G == 256) cvt_range(c, a, CVT_TILES - CVT_DEFER - CVT_DEFER_UP, CVT_TILES - CVT_DEFER, 128, 128);
        }
        SEAM(P + 8);
        if (IN(P + 9)) {
            pg8::Gemm g{DFF / 2, DFF / 2, DFF / 2}; pg8::DenseSched S; S.init(ws + WS_ACT, ws + WS_WD, DFF / 2, DFF / 2, NTOK, D, c.G, c.bid);
#ifdef XDOWN_EXP
            { pg8::EpiResid<false> Ed{nullptr, (us*)(ws + WS_XG), modl + 10240, 12288};
              pg8::gemm_phase<pg8::EpiResid<false>, pg8::DenseSched, false, true, true>(c.lds, g, S, Ed); xcd_barrier(bar); }
#endif
            if (fuse_norms) {
                pg8::EpiResidNorm<false, true> E{nullptr, (us*)(ws + WS_XB), modl + 10240, 12288, a.in[I_N1G] + D, modl + 4 * 12288, 0, 2048, ws + WS_H8, (us*)(ws + WS_H),
                                                 (unsigned*)(ws + WS_NSLOT) + (size_t)NTOK * 8, (unsigned*)(ws + WS_NCNT) + 32 * 64, (unsigned*)(ws + WS_BAR) + XB_TMO};
                pg8::gemm_phase<pg8::EpiResidNorm<false, true>, pg8::DenseSched, false, true, true>(c.lds, g, S, E);
            } else {
                pg8::EpiResid<false> E{nullptr, (us*)(ws + WS_XB), modl + 10240, 12288};
                pg8::gemm_phase<pg8::EpiResid<false>, pg8::DenseSched, false, true, true>(c.lds, g, S, E);
            }
        }
        SEAM(P + 9);
    } else {
        if (IN(P + 7)) REP(P + 7) moe_assign_phase(c, a);
        SEAM(P + 7);
        unsigned* mcnt = (unsigned*)(ws + WS_NCNT); const int* mctl = (const int*)(ws + WS_MOECTL);
        constexpr int NNU = 2 * DFFE / pg8::BM, NND = D / pg8::BM, ROT = 20;
        const int nT = mctl[0], nup = nT * NNU, ndn = nT * NND;
        const int sh = ((nup % c.G + 7) / 8 * 8) % c.G, c0 = (c.bid - sh + c.G) % c.G, rem = ndn % c.G;
        const int nearly = (sh > 0 && rem <= c.G - sh) ? rem : 0;
        volatile LAS unsigned* emw = (volatile LAS unsigned*)(c.lds + LDS_CTL + 32);
        if (c.tid < 3) emw[c.tid] = 0u;
        __syncthreads();
        if (c.tid < nearly) { int pm, pn; pg8::remap_moe(c.tid, ndn, nT, NND, 1, ROT, pm, pn); atomicOr((unsigned*)(emw + (pm >> 5)), 1u << (pm & 31)); }
        __syncthreads();
        const unsigned long long emlo = (unsigned long long)emw[0] | ((unsigned long long)emw[1] << 32); const unsigned emhi = emw[2];
        if (IN(P + 8)) {
            pg8::Gemm g{D / 2, D / 2, D / 2}; pg8::MoeSched S; S.init(ws + WS_H, ws + WS_MGU, D / 2, D / 2, (size_t)2 * DFFE * D, mctl, 2 * DFFE, c.G, c.bid, 2, 0); S.s2t = (const int*)(ws + WS_XG);
            pg8::EpiSwiglu<true> E{(us*)(ws + WS_ACT), DFFE, mcnt, emlo, emhi};
            pg8::gemm_phase<pg8::EpiSwiglu<true>, pg8::MoeSched, true, true, true, true>(c.lds, g, S, E);
        }
        const bool pre = c0 < nearly;
        if (IN(P + 9) && pre) {
            pg8::Gemm g{DFFE / 2, DFFE / 2, DFFE / 2}; pg8::MoeSched S; S.init(ws + WS_ACT, ws + WS_MD, DFFE / 2, DFFE / 2, (size_t)D * DFFE, mctl, D, c.G, c0, 1, ROT, 0, nearly);
            { int pm0, pn0; pg8::remap_moe(c0, ndn, nT, NND, 1, ROT, pm0, pn0); pg8::moe_wait(mcnt, pm0, (unsigned)NNU * 8u, (unsigned*)(ws + WS_BAR) + XB_TMO); __syncthreads(); }
            pg8::EpiBf16 E{(us*)(ws + WS_Y), D, 0};
            pg8::gemm_phase<pg8::EpiBf16, pg8::MoeSched, true, true, true>(c.lds, g, S, E);
        }
        SEAM(P + 8);
        if (IN(P + 9)) {
            pg8::Gemm g{DFFE / 2, DFFE / 2, DFFE / 2}; pg8::MoeSched S; S.init(ws + WS_ACT, ws + WS_MD, DFFE / 2, DFFE / 2, (size_t)D * DFFE, mctl, D, c.G, c0, 1, ROT, pre ? 1 : 0);
            pg8::EpiBf16 E{(us*)(ws + WS_Y), D, 0};
            pg8::gemm_phase<pg8::EpiBf16, pg8::MoeSched, true, true, true>(c.lds, g, S, E);
        }
        SEAM(P + 9);
    }
}

__global__ void __launch_bounds__(512, 2) mega(Args a) {
    extern __shared__ __attribute__((aligned(16))) unsigned char lds_raw[];
    Ctx c; c.lds = (LAS unsigned char*)lds_raw; c.tid = threadIdx.x; c.lane = c.tid & 63; c.wave = __builtin_amdgcn_readfirstlane(c.tid >> 6); c.G = gridDim.x; c.bid = blockIdx.x;
    volatile LAS unsigned* stw = (volatile LAS unsigned*)(c.lds + LDS_CTL);
    if (c.tid < 4) stw[c.tid] = 0u;
    __syncthreads();
    XcdBarrier bar; bar.bar = (unsigned*)(a.ws + WS_BAR); bar.x = 0; bar.st = stw;
    if (a.use_bar) bar = xcd_barrier_post((unsigned*)(a.ws + WS_BAR), stw);
#ifndef PROLOGUE_REPS
#define PROLOGUE_REPS 1
#endif
    if (IN(0)) {
#pragma unroll 1
        for (int pr_ = 0; pr_ < PROLOGUE_REPS; ++pr_) { prologue_phase(c, a); if (pr_ + 1 < PROLOGUE_REPS) xcd_barrier(bar); }
        if (IN(1)) {
            pg8::cnt_wait((unsigned*)(a.ws + WS_NCNT) + 48, 96u, (unsigned*)(a.ws + WS_BAR) + XB_TMO);
            __syncthreads();
            norm_phase<false, 2, false>(c, a, a.in[I_X], a.in[I_N1G], (const float*)(a.ws + WS_MOD), 0, 2048, (us*)(a.ws + WS_H), a.ws + WS_H8);
        }
    }
    SEAM(0);
    layer_phases<0>(c, a, bar);
    layer_phases<1>(c, a, bar);
    if (IN(23)) final_phase(c, a);
}
#undef IN
#undef SEAM

extern "C" void kernel_launch(void* const* d_in, const int* in_sizes, int n_in, void* d_out, int out_size, void* d_ws, size_t ws_size, hipStream_t stream) {
    static int grid = 0;
    if (grid == 0) {
        if (n_in != 25 || out_size != NTOK * D || ws_size < WS_END) { fprintf(stderr, "kernel_launch: unexpected shapes (n_in %d out %d ws %zu need %zu)\n", n_in, out_size, ws_size, (size_t)WS_END); grid = -1; return; }
        int dev = 0, cus = 0, per_cu = 0;
        if (hipGetDevice(&dev) != hipSuccess || hipDeviceGetAttribute(&cus, hipDeviceAttributeMultiprocessorCount, dev) != hipSuccess) { grid = -1; return; }
        if (hipFuncSetAttribute((const void*)mega, hipFuncAttributeMaxDynamicSharedMemorySize, LDS_BYTES) != hipSuccess) { fprintf(stderr, "kernel_launch: hipFuncSetAttribute failed\n"); grid = -1; return; }
        if (hipOccupancyMaxActiveBlocksPerMultiprocessor(&per_cu, (const void*)mega, 512, LDS_BYTES) != hipSuccess || per_cu < 1) { fprintf(stderr, "kernel_launch: occupancy query says %d\n", per_cu); }
        (void)hipGetLastError();
        grid = cus;
    }
    if (grid < 0) return;
    (void)hipMemsetAsync((char*)d_ws + WS_BAR, 0, 32768, stream);
    Args a{};
    for (int i = 0; i < 25; ++i) a.in[i] = (const float*)d_in[i];
    a.out = (float*)d_out; a.ws = (unsigned char*)d_ws; a.pad_ = 0;
#if MK_LAUNCH_PER_PHASE
    a.use_bar = 0;
    for (int p = 0; p < NPHASE; ++p) {
        if (p == 8 || p == 11 || p == 22) continue;
        a.lo = p; a.hi = p + 1;
        hipLaunchKernelGGL(mega, dim3(grid), dim3(512), LDS_BYTES, stream, a);
    }
#else
    a.use_bar = 1; a.lo = 0; a.hi = NPHASE;
    hipLaunchKernelGGL(mega, dim3(grid), dim3(512), LDS_BYTES, stream, a);
#endif
}
```

```cpp
#include <hip/hip_runtime.h>
#include <cstdio>
#include <cstdint>

#ifndef MK_LAUNCH_PER_PHASE
#define MK_LAUNCH_PER_PHASE 0
#endif

#ifndef JREP_MASK
#define JREP_MASK 0x0u
#endif
#define JREP(j) _Pragma("unroll") for (int jrep_ = 0; jrep_ < 1 + (int)(((JREP_MASK) >> (j)) & 1u); ++jrep_)
#define JEXTRA(j) if ((((JREP_MASK) >> (j)) & 1u) != 0u)
#define LAS __attribute__((address_space(3)))
typedef unsigned short us;
typedef unsigned long long u64;
typedef short bf16x8 __attribute__((ext_vector_type(8)));
typedef short bf16x4 __attribute__((ext_vector_type(4)));
typedef float f32x4 __attribute__((ext_vector_type(4)));
typedef float f32x2 __attribute__((ext_vector_type(2)));
typedef unsigned u32x4 __attribute__((ext_vector_type(4)));
typedef unsigned u32x2 __attribute__((ext_vector_type(2)));
typedef int i32x4 __attribute__((ext_vector_type(4)));
typedef int i32x8 __attribute__((ext_vector_type(8)));

constexpr int D = 2048, NB = 4, SEQ = 2048, NTOK = 8192;
constexpr int DPROJ = 5272, DPROJ_P = 5376;
constexpr int NP8 = 4608;
constexpr int C_GQ = 0, C_GK = 512, C_GV = 1024, C_GR = 2048, C_CQ = 3072, C_CKV = 3584, C_KPE = 3840, C_GLOW = 3904,
              C_DQ = 3920, C_DK = 4432, C_DV = 4560, C_IQ = 4688, C_IK = 5200, C_IW = 5264;
constexpr int DFF = 5632, DFFE = 2816, NEXP = 8;
constexpr int MOE_ROWS = 18432;
constexpr float EPS = 1e-6f;

constexpr size_t al256(size_t x) { return (x + 255) & ~(size_t)255; }
constexpr size_t WS_BAR = 0;
constexpr size_t WS_NCNT = 16384;
constexpr size_t WS_MOECTL = 32768;
constexpr size_t WS_MOD = WS_MOECTL + 1024;
constexpr size_t WS_CS = al256(WS_MOD + (size_t)2 * 4 * 12288 * 4);
constexpr size_t WS_RSTD = al256(WS_CS + (size_t)NTOK * 32 * 8);
constexpr size_t WS_ROUTE = al256(WS_RSTD + (size_t)2 * NTOK * 4);
constexpr size_t WS_WIN = al256(WS_ROUTE + (size_t)6 * NTOK * 4);
constexpr size_t WS_WUQ = al256(WS_WIN + (size_t)2 * DPROJ_P * D * 2);
constexpr size_t WS_WUKV = al256(WS_WUQ + (size_t)2 * 768 * 512 * 2);
constexpr size_t WS_WOUT = al256(WS_WUKV + (size_t)2 * 1024 * 256 * 2);
constexpr size_t WS_WGU = al256(WS_WOUT + (size_t)2 * D * D * 2);
constexpr size_t WS_WD = al256(WS_WGU + (size_t)2 * DFF * D * 2);
constexpr size_t WS_MGU = al256(WS_WD + (size_t)D * DFF * 2);
constexpr size_t WS_MD = al256(WS_MGU + (size_t)NEXP * 2 * DFFE * D * 2);
constexpr size_t WS_H = al256(WS_MD + (size_t)NEXP * D * DFFE * 2);
constexpr size_t WS_PROJ = al256(WS_H + (size_t)NTOK * D * 2);
constexpr size_t WS_Q = al256(WS_PROJ + (size_t)NTOK * DPROJ_P * 2);
constexpr size_t WS_KN = al256(WS_Q + (size_t)NTOK * 768 * 2);
constexpr size_t WS_VT = al256(WS_KN + (size_t)NTOK * 512 * 2);
constexpr size_t WS_KPE = al256(WS_VT + (size_t)512 * NTOK * 2);
constexpr size_t WS_DVT = al256(WS_KPE + (size_t)NTOK * 64 * 2);
constexpr size_t WS_MASK = al256(WS_DVT + (size_t)4 * 128 * 2048 * 2);
constexpr size_t WS_CKV = al256(WS_MASK + (size_t)NTOK * 32 * 8);
constexpr size_t WS_ST = al256(WS_CKV + (size_t)4 * 32 * 4 * 256 * 128 * 4);
constexpr size_t WS_DEC = al256(WS_ST + (size_t)4 * 32 * 4 * 256 * 128 * 2);
constexpr size_t WS_MIX = al256(WS_DEC + (size_t)4 * 32 * 4 * 128 * 4);
constexpr size_t WS_ACT = al256(WS_MIX + (size_t)NTOK * D * 2);
constexpr size_t WS_XG = al256(WS_ACT + (size_t)MOE_ROWS * DFFE * 2);
constexpr size_t WS_Y = al256(WS_XG + (size_t)MOE_ROWS * D * 2);
constexpr size_t WS_XB = al256(WS_Y + (size_t)MOE_ROWS * D * 2);
constexpr size_t WS_H8 = al256(WS_XB + (size_t)NTOK * D * 2);
constexpr size_t WS_WIN8 = al256(WS_H8 + (size_t)NTOK * D);
constexpr size_t WS_NSLOT = al256(WS_WIN8 + (size_t)2 * NP8 * D);
constexpr size_t WS_END = al256(WS_NSLOT + (size_t)2 * NTOK * 8 * 4);
static_assert((size_t)NTOK * DFF * 2 <= (size_t)MOE_ROWS * DFFE * 2, "act buffer");

constexpr int LDS_WORK = 131584;
constexpr int LDS_CTL = LDS_WORK;
constexpr int LDS_BYTES = LDS_WORK + 256;

__device__ __forceinline__ float bf2f(us b) { return __uint_as_float(((unsigned)b) << 16); }
__device__ __forceinline__ us f2bf(float f) { unsigned u = __float_as_uint(f); u += 0x7FFFu + ((u >> 16) & 1u); return (us)(u >> 16); }
__device__ __forceinline__ unsigned pk2(float lo, float hi) { return (unsigned)f2bf(lo) | ((unsigned)f2bf(hi) << 16); }
__device__ __forceinline__ unsigned pk4_fp8(float a, float b, float c, float d) { int w = 0; w = __builtin_amdgcn_cvt_pk_fp8_f32(a, b, w, false); w = __builtin_amdgcn_cvt_pk_fp8_f32(c, d, w, true); return (unsigned)w; }
#define DPP_ADD_F(v, ctrl, rmask) v += __builtin_bit_cast(float, __builtin_amdgcn_update_dpp(0, __builtin_bit_cast(int, v), ctrl, rmask, 0xf, false))
__device__ __forceinline__ float wave_sum(float v) {
    DPP_ADD_F(v, 0xB1, 0xf); DPP_ADD_F(v, 0x4E, 0xf); DPP_ADD_F(v, 0x141, 0xf); DPP_ADD_F(v, 0x140, 0xf); DPP_ADD_F(v, 0x142, 0xa); DPP_ADD_F(v, 0x143, 0xc);
    return __builtin_bit_cast(float, __builtin_amdgcn_readlane(__builtin_bit_cast(int, v), 63));
}
__device__ __forceinline__ int wave_sum_i(int v) {
#pragma unroll
    for (int o = 32; o > 0; o >>= 1) v += __shfl_xor(v, o);
    return v;
}
__device__ __forceinline__ float rows_max(float v) {
    { const auto r = __builtin_amdgcn_permlane16_swap(__float_as_uint(v), __float_as_uint(v), false, false); v = fmaxf(__uint_as_float(r[0]), __uint_as_float(r[1])); }
    { const auto r = __builtin_amdgcn_permlane32_swap(__float_as_uint(v), __float_as_uint(v), false, false); v = fmaxf(__uint_as_float(r[0]), __uint_as_float(r[1])); }
    return v;
}
__device__ __forceinline__ float rows_sum(float v) {
    { const auto r = __builtin_amdgcn_permlane16_swap(__float_as_uint(v), __float_as_uint(v), false, false); v = __uint_as_float(r[0]) + __uint_as_float(r[1]); }
    { const auto r = __builtin_amdgcn_permlane32_swap(__float_as_uint(v), __float_as_uint(v), false, false); v = __uint_as_float(r[0]) + __uint_as_float(r[1]); }
    return v;
}
__device__ __forceinline__ float siluf(float x) { return x * __builtin_amdgcn_rcpf(1.0f + __expf(-x)); }
__device__ __forceinline__ f32x4 mfma16(bf16x8 a, bf16x8 b, f32x4 c) { return __builtin_amdgcn_mfma_f32_16x16x32_bf16(a, b, c, 0, 0, 0); }
__device__ __forceinline__ bf16x8 ld8(const us* p) { return *(const bf16x8*)p; }

#define XB_TMO      128
#define XB_XCNT(j)  (256  + 64 * (j))
#define XB_XSUB(j)  (1280 + 64 * (j))
#define XB_XGEN(j)  (2304 + 64 * (j))
#define XB_TOP      3328
#define XB_TOPGEN   3392
#define XCD_BAR_WORDS 3456
#define XB_SPIN_CAP (1u << 22)

__device__ __forceinline__ unsigned xb_ld(unsigned* p)              { return __hip_atomic_load(p, __ATOMIC_RELAXED, __HIP_MEMORY_SCOPE_AGENT); }
__device__ __forceinline__ unsigned xb_add(unsigned* p, unsigned v) { return __hip_atomic_fetch_add(p, v, __ATOMIC_RELAXED, __HIP_MEMORY_SCOPE_AGENT); }
__device__ __forceinline__ unsigned xb_xcc_id() { return (unsigned)__builtin_amdgcn_s_getreg((3 << 11) | 20) & 0xFu; }
#define XB_SPIN(cond, bar) do { unsigned _sp = 0; while (cond) { __builtin_amdgcn_s_sleep(1); \
    if ((++_sp & 255u) == 0u) { if (xb_ld(&(bar)[XB_TMO])) break; if (_sp > XB_SPIN_CAP) { atomicAdd(&(bar)[XB_TMO], 1u); break; } } } } while (0)

struct XcdBarrier { unsigned* bar; unsigned x; volatile LAS unsigned* st; };

__device__ __forceinline__ XcdBarrier xcd_barrier_post(unsigned* bar, volatile LAS unsigned* st) {
    XcdBarrier b; b.bar = bar; b.x = xb_xcc_id(); b.st = st;
    if (threadIdx.x == 0) (void)xb_add(&bar[XB_XCNT(b.x)], 1u);
    return b;
}
__device__ __forceinline__ void xcd_barrier_complete(unsigned* bar, unsigned x, unsigned& nloc, unsigned& nx) {
    const unsigned G = gridDim.x * gridDim.y * gridDim.z;
    unsigned sum, cnt, mine, sp = 0u;
    for (;;) {
        sum = 0u; cnt = 0u; mine = 0u;
#pragma unroll
        for (unsigned j = 0; j < 16; ++j) { const unsigned c = xb_ld(&bar[XB_XCNT(j)]); sum += c; cnt += (c > 0u) ? 1u : 0u; mine = (j == x) ? c : mine; }
        if (sum == G) break;
        __builtin_amdgcn_s_sleep(1);
        if ((++sp & 255u) == 0u) { if (xb_ld(&bar[XB_TMO])) break; if (sp > XB_SPIN_CAP) { atomicAdd(&bar[XB_TMO], 1u); break; } }
    }
    nloc = mine > 0u ? mine : 1u; nx = cnt > 0u ? cnt : 1u;
}
__device__ __forceinline__ void xcd_barrier(const XcdBarrier& b) {
    asm volatile("s_waitcnt vmcnt(0)" ::: "memory");
    __syncthreads();
    if (threadIdx.x == 0) {
        unsigned* bar = b.bar;
        __builtin_amdgcn_s_waitcnt(0);
        unsigned nloc = b.st[0], nx = b.st[1];
        if (nloc == 0u) { xcd_barrier_complete(bar, b.x, nloc, nx); b.st[0] = nloc; b.st[1] = nx; }
        const unsigned old = xb_add(&bar[XB_XSUB(b.x)], 1u);
        const unsigned gen = old / nloc;
        if (old + 1u == (gen + 1u) * nloc) {
            __builtin_amdgcn_fence(__ATOMIC_RELEASE, "agent");
            asm volatile("s_waitcnt vmcnt(0)" ::: "memory");
            const unsigned og = xb_add(&bar[XB_TOP], 1u);
            const unsigned tg = og / nx;
            if (og + 1u == (tg + 1u) * nx) xb_add(&bar[XB_TOPGEN], 1u);
            else XB_SPIN(xb_ld(&bar[XB_TOPGEN]) == tg, bar);
            xb_add(&bar[XB_XGEN(b.x)], 1u);
            __builtin_amdgcn_fence(__ATOMIC_ACQUIRE, "agent");
            asm volatile("s_waitcnt vmcnt(0)" ::: "memory");
        } else {
            XB_SPIN(xb_ld(&bar[XB_XGEN(b.x)]) == gen, bar);
            __builtin_amdgcn_fence(__ATOMIC_ACQUIRE, "agent");
            asm volatile("s_waitcnt vmcnt(0)" ::: "memory");
        }
    }
    __syncthreads();
}

namespace pg8 {
constexpr int BM = 256, BK = 64, HALF = 128, HTB = HALF * BK * 2, STAGE_BYTES = 8 * HTB, NXCD = 8, WGM = 8;
__host__ __device__ __forceinline__ int lds_byte(int r, int c) { const int st = (r >> 4) * 2 + (c >> 5), rr = r & 15, cc = c & 31, ob = rr * 64 + cc * 2; return st * 1024 + (ob ^ (((ob >> 9) & 1) << 5)); }
__host__ __device__ __forceinline__ void stage_rc(int b, int& R, int& C) { const int st = b / 1024, sb = b % 1024, swz = sb ^ (((sb >> 9) & 1) << 5); R = (st >> 1) * 16 + swz / 64; C = (st & 1) * 32 + (swz % 64) / 2; }
__host__ __device__ __forceinline__ int perm32(int rho) { const int n = rho >> 4, i = rho & 15; return 8 * (i >> 2) + 4 * n + (i & 3); }

struct Unit { int pm, pn; const char* a; const char* b; };
struct Gemm { int lda, ldb, K; };

__device__ __forceinline__ void remap(int L, int nwg, int nM, int nN, int& pm, int& pn) {
    int wgid = L; { const int q = nwg / NXCD, r = nwg % NXCD, xcd = wgid % NXCD, off = wgid / NXCD; wgid = (xcd < r ? xcd * (q + 1) : r * (q + 1) + (xcd - r) * q) + off; }
    const int nig = WGM * nN, gid = wgid / nig, fm = gid * WGM, gsz = (nM - fm) < WGM ? (nM - fm) : WGM;
    pm = fm + ((wgid % nig) % gsz); pn = (wgid % nig) / gsz;
}
struct DenseSched {
    const char* A; const char* B; size_t tA, tB; int nM, nN, nwg, G, c, base, lim;
    __device__ __forceinline__ void init(const void* A_, const void* B_, int lda, int ldb, int M, int N, int G_, int c_, int base_ = 0, int lim_ = 0x7fffffff) { A = (const char*)A_; B = (const char*)B_; tA = (size_t)BM * lda * 2; tB = (size_t)BM * ldb * 2; nM = M / BM; nN = N / BM; nwg = nM * nN; G = G_; c = c_; base = base_; lim = lim_ < nwg ? lim_ : nwg; }
    __device__ __forceinline__ bool next(int i, Unit& u) const {
        const long L = (long)base + (long)i * G + c; if (c < 0 || L >= lim) return false;
        remap((int)L, nwg, nM, nN, u.pm, u.pn); u.a = A + (size_t)u.pm * tA; u.b = B + (size_t)u.pn * tB; return true;
    }
};
__device__ __forceinline__ void remap_moe(int L, int nwg, int nM, int nN, int wgm, int rot, int& pm, int& pn) {
    const int q = nwg / NXCD, r = nwg % NXCD, xcd = L % NXCD; int off = L / NXCD;
    const int len = q + (xcd < r ? 1 : 0), start = xcd < r ? xcd * (q + 1) : r * (q + 1) + (xcd - r) * q;
    if (rot > 0) { const int re = rot + (nN - (start + rot) % nN) % nN; if (re < len) { off += re; if (off >= len) off -= len; } }
    const int wgid = start + off, nig = wgm * nN, gid = wgid / nig, fm = gid * wgm, gsz = (nM - fm) < wgm ? (nM - fm) : wgm;
    pm = fm + ((wgid % nig) % gsz); pn = (wgid % nig) / gsz;
}
__device__ __forceinline__ unsigned* moe_cnt(unsigned* base, int t) { return base + 16 + (t & 63) * 64 + (t >> 6) * 16; }
struct MoeSched {
    const char* A; const char* B; size_t tA, tB, eB; const int* tile_e; const int* s2t; int nM, nN, nwg, G, c, wgm, rot, i0, lim;
    __device__ __forceinline__ void init(const void* A_, const void* B_, int lda, int ldb, size_t eB_, const int* ctl, int N, int G_, int c_, int wgm_, int rot_, int i0_ = 0, int lim_ = 0x7fffffff) {
        A = (const char*)A_; B = (const char*)B_; tA = (size_t)BM * lda * 2; tB = (size_t)BM * ldb * 2; eB = eB_;
        nM = ctl[0]; tile_e = ctl + 16; nN = N / BM; nwg = nM * nN; G = G_; c = c_; wgm = wgm_; rot = rot_; i0 = i0_; lim = lim_ < nwg ? lim_ : nwg; s2t = nullptr; }
    __device__ __forceinline__ bool next(int i, Unit& u) const {
        const long L = (long)(i + i0) * G + c; if (L >= lim) return false;
        remap_moe((int)L, nwg, nM, nN, wgm, rot, u.pm, u.pn); u.a = s2t != nullptr ? A : A + (size_t)u.pm * tA; u.b = B + (size_t)tile_e[u.pm] * eB + (size_t)u.pn * tB; return true;
    }
};
__device__ __forceinline__ void cnt_wait(unsigned* p, unsigned need, unsigned* tmo) {
    if (__builtin_amdgcn_readfirstlane((int)threadIdx.x >> 6) == 0) { unsigned sp = 0;
        while ((unsigned)__builtin_amdgcn_readfirstlane(__hip_atomic_load(p, __ATOMIC_RELAXED, __HIP_MEMORY_SCOPE_AGENT)) < need) {
            __builtin_amdgcn_s_sleep(1);
            if ((++sp & 255u) == 0u) { if (__hip_atomic_load(tmo, __ATOMIC_RELAXED, __HIP_MEMORY_SCOPE_AGENT)) break; if (sp > XB_SPIN_CAP) { if ((threadIdx.x & 63) == 0) atomicAdd(tmo, 1u); break; } } }
        __builtin_amdgcn_fence(__ATOMIC_ACQUIRE, "agent");
        asm volatile("s_waitcnt vmcnt(0)" ::: "memory"); }
}
__device__ __forceinline__ void moe_wait(unsigned* cnt, int pm, unsigned need, unsigned* tmo) { cnt_wait(moe_cnt(cnt, pm), need, tmo); }

template <class Epi, class Sched, bool ALIGN_EPI = false, bool SP2 = true, bool FP8 = false, bool GA = false>
__device__ __forceinline__ void gemm_phase(LAS unsigned char* lds, const Gemm g, const Sched& S, const Epi& E) {
    const int tid = threadIdx.x, wid = __builtin_amdgcn_readfirstlane(tid >> 6), lane = tid & 63, wr = wid >> 2, wc = wid & 3, fr = lane & 15, fq = lane >> 4;
    int Kq = g.K; asm volatile("" : "+s"(Kq));
    const int K = Kq, nt = K / BK;
    static_assert(!GA || SP2, "gathered A rows: SP2 schedule only");
    unsigned voffA[2], voffB[2], voffA1[2] = {0u, 0u}, nvA[2] = {0u, 0u}, nvA1[2] = {0u, 0u};
#pragma unroll
    for (int i = 0; i < 2; ++i) { int R, C; stage_rc(tid * 16 + i * 8192, R, C); const int Rb = Epi::PERM ? ((R & ~31) + perm32(R & 31)) : R;
        voffA[i] = (unsigned)(R * g.lda + C) * 2u; voffB[i] = (unsigned)(Rb * g.ldb + C) * 2u; }
#define PG8_GA_LOAD(pm_, o0, o1) do { _Pragma("unroll") for (int _i = 0; _i < 2; ++_i) { int R_, C_; stage_rc(tid * 16 + _i * 8192, R_, C_); \
        const int t0_ = S.s2t[(pm_) * BM + R_], t1_ = S.s2t[(pm_) * BM + HALF + R_]; o0[_i] = (unsigned)(t0_ * g.lda + C_) * 2u; o1[_i] = (unsigned)(t1_ * g.lda + C_) * 2u; } \
        asm volatile("" : "+v"(o0[0]), "+v"(o0[1]), "+v"(o1[0]), "+v"(o1[1])); } while (0)
    const size_t kstep = (size_t)(BK * 2);
    const size_t hstepA = (size_t)HALF * g.lda * 2, hstepB = (size_t)HALF * g.ldb * 2;
    const unsigned ldsw = (unsigned)wid * 1024u;
    const int aoff = lds_byte(wr * 64 + fr, fq * 8), boff = lds_byte(wc * 32 + fr, fq * 8);
#define PG8_SA(b, h) (((b) * 2 + (h)) * HTB)
#define PG8_SB(b, h) ((4 + (b) * 2 + (h)) * HTB)
#define PG8_STAGE(bufoff, gbase, voff) do { _Pragma("unroll") for (int _i = 0; _i < 2; ++_i) \
        __builtin_amdgcn_global_load_lds((const unsigned*)((const char*)(gbase) + (voff)[_i]), (LAS unsigned*)(lds + (bufoff) + ldsw + _i * 8192), 16, 0, 0); } while (0)
#define PG8_STA(bufoff, base, h, sel) do { if constexpr (GA) { const unsigned o_[2] = {(sel) ? ((h) ? nvA1[0] : nvA[0]) : ((h) ? voffA1[0] : voffA[0]), (sel) ? ((h) ? nvA1[1] : nvA[1]) : ((h) ? voffA1[1] : voffA[1])}; PG8_STAGE(bufoff, base, o_); } \
        else PG8_STAGE(bufoff, (base) + ((h) ? hstepA : (size_t)0), voffA); } while (0)
#define PG8_LDA(dst, b, h) do { _Pragma("unroll") for (int m = 0; m < 4; ++m) { if constexpr (FP8) { const i32x4 lo_ = *(const LAS i32x4*)(lds + PG8_SA(b, h) + aoff + m * 2048), hi_ = *(const LAS i32x4*)(lds + PG8_SA(b, h) + aoff + m * 2048 + 1024); \
        dst##8[m] = __builtin_shufflevector(lo_, hi_, 0, 1, 2, 3, 4, 5, 6, 7); } else { _Pragma("unroll") for (int k = 0; k < 2; ++k) dst[m][k] = *(const LAS bf16x8*)(lds + PG8_SA(b, h) + aoff + m * 2048 + k * 1024); } } } while (0)
#define PG8_LDB(dst, b, h) do { _Pragma("unroll") for (int n = 0; n < 2; ++n) { if constexpr (FP8) { const i32x4 lo_ = *(const LAS i32x4*)(lds + PG8_SB(b, h) + boff + n * 2048), hi_ = *(const LAS i32x4*)(lds + PG8_SB(b, h) + boff + n * 2048 + 1024); \
        dst##8[n] = __builtin_shufflevector(lo_, hi_, 0, 1, 2, 3, 4, 5, 6, 7); } else { _Pragma("unroll") for (int k = 0; k < 2; ++k) dst[n][k] = *(const LAS bf16x8*)(lds + PG8_SB(b, h) + boff + n * 2048 + k * 1024); } } } while (0)
#define PG8_MMA(ai, bj, At, Bt) do { __builtin_amdgcn_s_setprio(1); _Pragma("unroll") for (int m = 0; m < 4; ++m) _Pragma("unroll") for (int n = 0; n < 2; ++n) { \
        if constexpr (FP8) asm volatile("v_mfma_scale_f32_16x16x128_f8f6f4 %0, %1, %2, %0, %3, %3 op_sel_hi:[0,0,0]" : "+v"(acc[ai][bj][m][n]) : "v"(Bt##8[n]), "v"(At##8[m]), "v"(sc8)); \
        else { _Pragma("unroll") for (int k = 0; k < 2; ++k) acc[ai][bj][m][n] = __builtin_amdgcn_mfma_f32_16x16x32_bf16(Bt[n][k], At[m][k], acc[ai][bj][m][n], 0, 0, 0); } } \
        __builtin_amdgcn_s_setprio(0); } while (0)
#define PG8_WAIT_V(n) asm volatile("s_waitcnt vmcnt(" #n ")" ::: "memory")
#define PG8_WAIT_L(n) asm volatile("s_waitcnt lgkmcnt(" #n ")" ::: "memory")
#define PG8_BAR __builtin_amdgcn_s_barrier()
#define PG8_SCHED __builtin_amdgcn_sched_barrier(0)
    Unit cur, nxt; int ui = 0;
    if (!S.next(0, cur)) return;
    f32x4 acc[2][2][4][2];
#pragma unroll
    for (int a = 0; a < 2; ++a)
#pragma unroll
        for (int b = 0; b < 2; ++b)
#pragma unroll
            for (int m = 0; m < 4; ++m)
#pragma unroll
                for (int n = 0; n < 2; ++n) acc[a][b][m][n] = (f32x4){0.f, 0.f, 0.f, 0.f};
    bf16x8 At[4][2], B0[2][2], B1[2][2];
    i32x8 At8[4], B08[2], B18[2];
    int sc8 = 0; if constexpr (FP8) asm volatile("v_mov_b32 %0, 0x7c7c7c7c\n\ts_nop 4" : "=v"(sc8));
    const char* cA = cur.a; const char* cB = cur.b;
    if constexpr (GA) PG8_GA_LOAD(cur.pm, voffA, voffA1);
    if constexpr (SP2) {
        PG8_STAGE(PG8_SB(0, 0), cB, voffB); PG8_STAGE(PG8_SB(0, 1), cB + hstepB, voffB); PG8_STA(PG8_SA(0, 0), cA, 0, false); PG8_STA(PG8_SA(0, 1), cA, 1, false);
        if (wr == 1) PG8_BAR;
        PG8_WAIT_V(2); PG8_BAR;
        PG8_STAGE(PG8_SB(1, 0), cB + kstep, voffB); PG8_STA(PG8_SA(1, 0), cA + kstep, 0, false); PG8_STAGE(PG8_SB(1, 1), cB + hstepB + kstep, voffB);
        PG8_WAIT_V(6); PG8_BAR;
    } else {
        PG8_STAGE(PG8_SB(0, 0), cB, voffB); PG8_STAGE(PG8_SA(0, 0), cA, voffA); PG8_STAGE(PG8_SB(0, 1), cB + hstepB, voffB); PG8_STAGE(PG8_SA(0, 1), cA + hstepA, voffA);
        if (wr == 1) PG8_BAR;
        PG8_WAIT_V(4); PG8_BAR;
        PG8_STAGE(PG8_SB(1, 0), cB + kstep, voffB); PG8_STAGE(PG8_SA(1, 0), cA + kstep, voffA); PG8_STAGE(PG8_SB(1, 1), cB + hstepB + kstep, voffB);
        PG8_WAIT_V(6); PG8_BAR;
    }
    for (;;) {
        const bool has_next = S.next(ui + 1, nxt);
        const char* nA = has_next ? nxt.a : cA; const char* nB = has_next ? nxt.b : cB;
        if constexpr (GA) { if (has_next) PG8_GA_LOAD(nxt.pm, nvA, nvA1); else { nvA[0] = voffA[0]; nvA[1] = voffA[1]; nvA1[0] = voffA1[0]; nvA1[1] = voffA1[1]; } }
#pragma unroll 1
        for (int t = 0; t < nt; t += 2) {
            const bool last = (t == nt - 2);
            const char* a1 = cA + (size_t)(t + 1) * kstep;
            const char* a2 = last ? nA : cA + (size_t)(t + 2) * kstep; const char* b2 = last ? nB : cB + (size_t)(t + 2) * kstep;
            const char* a3 = a2 + kstep; const char* b3 = b2 + kstep;
            if constexpr (SP2) {
            PG8_LDB(B0, 0, 0); PG8_LDB(B1, 0, 1); PG8_SCHED; PG8_LDA(At, 0, 0); PG8_STA(PG8_SA(1, 1), a1, 1, false);
            PG8_WAIT_V(8); PG8_WAIT_L(0); PG8_BAR; PG8_MMA(0, 0, At, B0); PG8_MMA(0, 1, At, B1); PG8_BAR; PG8_SCHED;
            PG8_LDA(At, 0, 1); PG8_STAGE(PG8_SB(0, 0), b2, voffB); PG8_STAGE(PG8_SB(0, 1), b2 + hstepB, voffB); PG8_STA(PG8_SA(0, 0), a2, 0, last);
            PG8_WAIT_V(8); PG8_WAIT_L(0); PG8_BAR; PG8_MMA(1, 0, At, B0); PG8_MMA(1, 1, At, B1); PG8_BAR; PG8_SCHED;
            PG8_LDB(B0, 1, 0); PG8_LDB(B1, 1, 1); PG8_SCHED; PG8_LDA(At, 1, 0); PG8_STA(PG8_SA(0, 1), a2, 1, last);
            PG8_WAIT_V(8); PG8_WAIT_L(0); PG8_BAR; PG8_MMA(0, 0, At, B0); PG8_MMA(0, 1, At, B1); PG8_BAR; PG8_SCHED;
            PG8_LDA(At, 1, 1); PG8_STAGE(PG8_SB(1, 0), b3, voffB); PG8_STAGE(PG8_SB(1, 1), b3 + hstepB, voffB); PG8_STA(PG8_SA(1, 0), a3, 0, last);
            PG8_WAIT_V(8); PG8_WAIT_L(0); PG8_BAR; PG8_MMA(1, 0, At, B0); PG8_MMA(1, 1, At, B1); PG8_BAR; PG8_SCHED;
            } else {
            PG8_LDB(B0, 0, 0); PG8_SCHED; PG8_LDA(At, 0, 0); PG8_STAGE(PG8_SA(1, 1), a1 + hstepA, voffA);
            PG8_WAIT_L(8); PG8_BAR; PG8_WAIT_L(0); PG8_MMA(0, 0, At, B0); PG8_BAR; PG8_SCHED;
            PG8_LDB(B1, 0, 1); PG8_STAGE(PG8_SB(0, 0), b2, voffB);
            PG8_BAR; PG8_WAIT_L(0); PG8_MMA(0, 1, At, B1); PG8_BAR;
            PG8_LDA(At, 0, 1); PG8_STAGE(PG8_SA(0, 0), a2, voffA);
            PG8_BAR; PG8_WAIT_L(0); PG8_MMA(1, 0, At, B0); PG8_BAR; PG8_SCHED;
            PG8_STAGE(PG8_SB(0, 1), b2 + hstepB, voffB);
            PG8_WAIT_V(6); PG8_BAR; PG8_MMA(1, 1, At, B1); PG8_BAR;
            PG8_LDB(B0, 1, 0); PG8_SCHED; PG8_LDA(At, 1, 0); PG8_STAGE(PG8_SA(0, 1), a2 + hstepA, voffA);
            PG8_WAIT_L(8); PG8_BAR; PG8_WAIT_L(0); PG8_MMA(0, 0, At, B0); PG8_BAR; PG8_SCHED;
            PG8_LDB(B1, 1, 1); PG8_STAGE(PG8_SB(1, 0), b3, voffB);
            PG8_BAR; PG8_WAIT_L(0); PG8_MMA(0, 1, At, B1); PG8_BAR;
            PG8_LDA(At, 1, 1); PG8_STAGE(PG8_SA(1, 0), a3, voffA);
            PG8_BAR; PG8_WAIT_L(0); PG8_MMA(1, 0, At, B0); PG8_BAR; PG8_SCHED;
            PG8_STAGE(PG8_SB(1, 1), b3 + hstepB, voffB);
            PG8_WAIT_V(6); PG8_BAR; PG8_MMA(1, 1, At, B1); PG8_BAR;
            }
        }
        if constexpr (ALIGN_EPI) { if (wr == 0) PG8_BAR; }
        asm volatile("s_nop 15\n\ts_nop 15" : "+v"(acc[0][0][0][0]), "+v"(acc[0][0][0][1]), "+v"(acc[0][0][1][0]), "+v"(acc[0][0][1][1]), "+v"(acc[0][0][2][0]), "+v"(acc[0][0][2][1]), "+v"(acc[0][0][3][0]), "+v"(acc[0][0][3][1]), "+v"(acc[0][1][0][0]), "+v"(acc[0][1][0][1]), "+v"(acc[0][1][1][0]), "+v"(acc[0][1][1][1]), "+v"(acc[0][1][2][0]), "+v"(acc[0][1][2][1]), "+v"(acc[0][1][3][0]), "+v"(acc[0][1][3][1]), "+v"(acc[1][0][0][0]), "+v"(acc[1][0][0][1]), "+v"(acc[1][0][1][0]), "+v"(acc[1][0][1][1]), "+v"(acc[1][0][2][0]), "+v"(acc[1][0][2][1]), "+v"(acc[1][0][3][0]), "+v"(acc[1][0][3][1]), "+v"(acc[1][1][0][0]), "+v"(acc[1][1][0][1]), "+v"(acc[1][1][1][0]), "+v"(acc[1][1][1][1]), "+v"(acc[1][1][2][0]), "+v"(acc[1][1][2][1]), "+v"(acc[1][1][3][0]), "+v"(acc[1][1][3][1]) :: "memory");
        if constexpr (!Epi::AFTER_DRAIN) E(acc, cur, wr, wc, fr, fq);
        if (!has_next) break;
#pragma unroll
        for (int a = 0; a < 2; ++a)
#pragma unroll
            for (int b = 0; b < 2; ++b)
#pragma unroll
                for (int m = 0; m < 4; ++m)
#pragma unroll
                    for (int n = 0; n < 2; ++n) acc[a][b][m][n] = (f32x4){0.f, 0.f, 0.f, 0.f};
        cur = nxt; cA = nA; cB = nB; ++ui;
        if constexpr (GA) { voffA[0] = nvA[0]; voffA[1] = nvA[1]; voffA1[0] = nvA1[0]; voffA1[1] = nvA1[1]; }
        if constexpr (ALIGN_EPI) { if (wr == 1) PG8_BAR; }
    }
    PG8_WAIT_V(0);
    if constexpr (!ALIGN_EPI) { if (wr == 0) PG8_BAR; }
    PG8_BAR;
    if constexpr (Epi::AFTER_DRAIN) E.fused(acc, cur, wr, wc, fr, fq, lds, wid, lane);
#undef PG8_SA
#undef PG8_SB
#undef PG8_STAGE
#undef PG8_STA
#undef PG8_GA_LOAD
#undef PG8_LDA
#undef PG8_LDB
#undef PG8_MMA
#undef PG8_WAIT_V
#undef PG8_WAIT_L
#undef PG8_BAR
#undef PG8_SCHED
}

typedef f32x4 Acc[2][2][4][2];
__device__ __forceinline__ unsigned cvt_pk_bf16(float lo, float hi) { unsigned r; asm volatile("v_cvt_pk_bf16_f32 %0, %1, %2" : "=v"(r) : "v"(lo), "v"(hi)); return r; }
__device__ __forceinline__ unsigned cvt_pk_bf16_t(float lo, float hi) { unsigned r; asm volatile("s_nop 0\n\tv_cvt_pk_bf16_f32 %0, %1, %2" : "=v"(r) : "v"(lo), "v"(hi)); return r; }

#ifndef EMU_F8
#define EMU_F8 0
#endif
struct EpiBf16 {
    static constexpr bool PERM = true, AFTER_DRAIN = false;
    us* O; int ldc; int emu;
    __device__ __forceinline__ void operator()(const Acc& acc_, const Unit& u, int wr, int wc, int fr, int fq) const {
        Acc acc;
#pragma unroll
        for (int a = 0; a < 2; ++a)
#pragma unroll
            for (int b = 0; b < 2; ++b)
#pragma unroll
                for (int m = 0; m < 4; ++m)
#pragma unroll
                    for (int n = 0; n < 2; ++n) acc[a][b][m][n] = acc_[a][b][m][n];
        if (EMU_F8 && emu && ((u.pn >= 4 && u.pn <= 10) || (u.pn >= 12 && u.pn <= 14))) {
#pragma unroll
            for (int a = 0; a < 2; ++a)
#pragma unroll
                for (int b = 0; b < 2; ++b)
#pragma unroll
                    for (int m = 0; m < 4; ++m)
#pragma unroll
                        for (int n = 0; n < 2; ++n) { const int w0 = __builtin_amdgcn_cvt_pk_fp8_f32(acc[a][b][m][n][0], acc[a][b][m][n][1], 0, false), w1 = __builtin_amdgcn_cvt_pk_fp8_f32(acc[a][b][m][n][2], acc[a][b][m][n][3], 0, false);
                            acc[a][b][m][n] = (f32x4){__builtin_amdgcn_cvt_f32_fp8(w0, 0), __builtin_amdgcn_cvt_f32_fp8(w0, 1), __builtin_amdgcn_cvt_f32_fp8(w1, 0), __builtin_amdgcn_cvt_f32_fp8(w1, 1)}; }
        }
        const int row0 = u.pm * BM + wr * 64 + fr, col0 = u.pn * BM + wc * 32 + 8 * fq;
#pragma unroll
        for (int ai = 0; ai < 2; ++ai)
#pragma unroll
            for (int m = 0; m < 4; ++m) { us* rowp = O + (size_t)(row0 + ai * HALF + m * 16) * ldc + col0;
#pragma unroll
                for (int bj = 0; bj < 2; ++bj) { const f32x4 v0 = acc[ai][bj][m][0], v1 = acc[ai][bj][m][1];
                    u32x4 w; w.x = cvt_pk_bf16(v0[0], v0[1]); w.y = cvt_pk_bf16(v0[2], v0[3]); w.z = cvt_pk_bf16(v1[0], v1[1]); w.w = cvt_pk_bf16(v1[2], v1[3]);
                    *(u32x4*)(rowp + bj * HALF) = w; } }
    }
};
struct EpiScaleRow {
    static constexpr bool PERM = true, AFTER_DRAIN = false;
    us* O; int ldc; const float* rs;
    __device__ __forceinline__ void operator()(const Acc& acc, const Unit& u, int wr, int wc, int fr, int fq) const {
        const int row0 = u.pm * BM + wr * 64 + fr, col0 = u.pn * BM + wc * 32 + 8 * fq;
        float sv[2][4];
#pragma unroll
        for (int ai = 0; ai < 2; ++ai)
#pragma unroll
            for (int m = 0; m < 4; ++m) sv[ai][m] = rs[row0 + ai * HALF + m * 16];
        __builtin_amdgcn_sched_barrier(0);
#pragma unroll
        for (int ai = 0; ai < 2; ++ai)
#pragma unroll
            for (int m = 0; m < 4; ++m) { const int row = row0 + ai * HALF + m * 16; const float s = sv[ai][m]; us* rowp = O + (size_t)row * ldc + col0;
#pragma unroll
                for (int bj = 0; bj < 2; ++bj) { const f32x4 v0 = acc[ai][bj][m][0] * s, v1 = acc[ai][bj][m][1] * s;
                    u32x4 w; w.x = cvt_pk_bf16(v0[0], v0[1]); w.y = cvt_pk_bf16(v0[2], v0[3]); w.z = cvt_pk_bf16(v1[0], v1[1]); w.w = cvt_pk_bf16(v1[2], v1[3]);
                    *(u32x4*)(rowp + bj * HALF) = w; } }
    }
};
struct EpiScaleCol {
    static constexpr bool PERM = true, AFTER_DRAIN = false;
    us* O; int ldc; const float* cs;
    __device__ __forceinline__ void operator()(const Acc& acc, const Unit& u, int wr, int wc, int fr, int fq) const {
        const int row0 = u.pm * BM + wr * 64 + fr, col0 = u.pn * BM + wc * 32 + 8 * fq;
        f32x4 sc[2][2];
#pragma unroll
        for (int bj = 0; bj < 2; ++bj)
#pragma unroll
            for (int n = 0; n < 2; ++n) sc[bj][n] = *(const f32x4*)(cs + col0 + bj * HALF + 4 * n);
#pragma unroll
        for (int ai = 0; ai < 2; ++ai)
#pragma unroll
            for (int m = 0; m < 4; ++m) { us* rowp = O + (size_t)(row0 + ai * HALF + m * 16) * ldc + col0;
#pragma unroll
                for (int bj = 0; bj < 2; ++bj) { const f32x4 v0 = acc[ai][bj][m][0] * sc[bj][0], v1 = acc[ai][bj][m][1] * sc[bj][1];
                    u32x4 w; w.x = cvt_pk_bf16(v0[0], v0[1]); w.y = cvt_pk_bf16(v0[2], v0[3]); w.z = cvt_pk_bf16(v1[0], v1[1]); w.w = cvt_pk_bf16(v1[2], v1[3]);
                    *(u32x4*)(rowp + bj * HALF) = w; } }
    }
};
struct EpiQRope {
    static constexpr bool PERM = true, AFTER_DRAIN = false;
    us* O; const float* rs; const float* cstab;
    __device__ __forceinline__ void operator()(const Acc& acc, const Unit& u, int wr, int wc, int fr, int fq) const {
        const int row0 = u.pm * BM + wr * 64 + fr, col0 = u.pn * BM + wc * 32 + 8 * fq;
        const int w0 = col0 % 192, w1 = (col0 + HALF) % 192;
        const int ropeh = w0 >= 128 ? 0 : (w1 >= 128 ? 1 : -1), wsel = w0 >= 128 ? w0 : (w1 >= 128 ? w1 : 128);
#pragma unroll
        for (int ai = 0; ai < 2; ++ai) {
            float sv[4]; f32x4 ca[4], cb[4];
#pragma unroll
            for (int m = 0; m < 4; ++m) { const int row = row0 + ai * HALF + m * 16; sv[m] = rs[row];
                const float* cp = cstab + ((size_t)row * 32 + (wsel - 128) / 2) * 2; ca[m] = *(const f32x4*)cp; cb[m] = *(const f32x4*)(cp + 4); }
            __builtin_amdgcn_sched_barrier(0);
#pragma unroll
            for (int m = 0; m < 4; ++m) { const int row = row0 + ai * HALF + m * 16; const float s = sv[m]; us* rowp = O + (size_t)row * 768 + col0;
#pragma unroll
                for (int bj = 0; bj < 2; ++bj) { f32x4 v0 = acc[ai][bj][m][0] * s, v1 = acc[ai][bj][m][1] * s;
                    if (bj == ropeh) {
                        const f32x4 c01 = ca[m], c23 = cb[m];
                        const f32x4 a = v0, b = v1;
                        v0[0] = a[0] * c01[0] - a[1] * c01[1]; v0[1] = a[0] * c01[1] + a[1] * c01[0];
                        v0[2] = a[2] * c01[2] - a[3] * c01[3]; v0[3] = a[2] * c01[3] + a[3] * c01[2];
                        v1[0] = b[0] * c23[0] - b[1] * c23[1]; v1[1] = b[0] * c23[1] + b[1] * c23[0];
                        v1[2] = b[2] * c23[2] - b[3] * c23[3]; v1[3] = b[2] * c23[3] + b[3] * c23[2];
                    }
                    u32x4 w; w.x = cvt_pk_bf16(v0[0], v0[1]); w.y = cvt_pk_bf16(v0[2], v0[3]); w.z = cvt_pk_bf16(v1[0], v1[1]); w.w = cvt_pk_bf16(v1[2], v1[3]);
                    *(u32x4*)(rowp + bj * HALF) = w; } }
            __builtin_amdgcn_sched_barrier(0);
        }
    }
};
template <bool IN_F32>
struct EpiResid {
    static constexpr bool PERM = true, AFTER_DRAIN = false;
    const float* xin32; us* xb; const float* gate;
    int gstride;
    __device__ __forceinline__ void operator()(const Acc& acc, const Unit& u, int wr, int wc, int fr, int fq) const {
        const int row0 = u.pm * BM + wr * 64 + fr, col0 = u.pn * BM + wc * 32 + 8 * fq;
        const float* gp = gate + (size_t)((u.pm * BM) >> 11) * gstride + col0;
        f32x4 gv[2][2];
#pragma unroll
        for (int bj = 0; bj < 2; ++bj)
#pragma unroll
            for (int n = 0; n < 2; ++n) gv[bj][n] = *(const f32x4*)(gp + bj * HALF + 4 * n);
#pragma unroll
        for (int ai = 0; ai < 2; ++ai)
#pragma unroll
            for (int mh = 0; mh < 2; ++mh) {
                f32x4 x0[2][2], x1[2][2];
#pragma unroll
                for (int mm = 0; mm < 2; ++mm) { const int m = 2 * mh + mm; const size_t ro = (size_t)(row0 + ai * HALF + m * 16) * D + col0;
#pragma unroll
                    for (int bj = 0; bj < 2; ++bj) {
                        if (IN_F32) { x0[mm][bj] = *(const f32x4*)(xin32 + ro + bj * HALF); x1[mm][bj] = *(const f32x4*)(xin32 + ro + bj * HALF + 4); }
                        else { const u32x4 xw = *(const u32x4*)(xb + ro + bj * HALF);
                            x0[mm][bj] = (f32x4){__uint_as_float(xw.x << 16), __uint_as_float(xw.x & 0xFFFF0000u), __uint_as_float(xw.y << 16), __uint_as_float(xw.y & 0xFFFF0000u)};
                            x1[mm][bj] = (f32x4){__uint_as_float(xw.z << 16), __uint_as_float(xw.z & 0xFFFF0000u), __uint_as_float(xw.w << 16), __uint_as_float(xw.w & 0xFFFF0000u)}; } } }
                __builtin_amdgcn_sched_barrier(0);
#pragma unroll
                for (int mm = 0; mm < 2; ++mm) { const int m = 2 * mh + mm; const size_t ro = (size_t)(row0 + ai * HALF + m * 16) * D + col0;
#pragma unroll
                    for (int bj = 0; bj < 2; ++bj) {
                        const f32x4 v0 = x0[mm][bj] + gv[bj][0] * acc[ai][bj][m][0], v1 = x1[mm][bj] + gv[bj][1] * acc[ai][bj][m][1];
                        u32x4 w; w.x = cvt_pk_bf16(v0[0], v0[1]); w.y = cvt_pk_bf16(v0[2], v0[3]); w.z = cvt_pk_bf16(v1[0], v1[1]); w.w = cvt_pk_bf16(v1[2], v1[3]);
                        *(u32x4*)(xb + ro + bj * HALF) = w; } }
                __builtin_amdgcn_sched_barrier(0);
            }
    }
};
template <bool IN_F32, bool OUT16>
struct EpiResidNorm {
    static constexpr bool PERM = true, AFTER_DRAIN = true;
    const float* xin32; us* xb; const float* gate; int gstride;
    const float* g; const float* modb; int sh_off, sc_off;
    unsigned char* h8; us* h16;
    unsigned* slots; unsigned* cnt; unsigned* tmo;
    __device__ __forceinline__ void operator()(const Acc&, const Unit&, int, int, int, int) const {}
    __device__ __forceinline__ void fused(Acc& acc, const Unit& u, int wr, int wc, int fr, int fq, LAS unsigned char* lds, int wid, int lane) const {
        const int row0 = u.pm * BM + wr * 64 + fr, col0 = u.pn * BM + wc * 32 + 8 * fq, bb = (u.pm * BM) >> 11;
        LAS float* P = (LAS float*)lds;
        LAS float* S = (LAS float*)(lds + 4096);
        {
            const float* gp = gate + (size_t)bb * gstride + col0;
            f32x4 gv[2][2];
#pragma unroll
            for (int bj = 0; bj < 2; ++bj)
#pragma unroll
                for (int n = 0; n < 2; ++n) gv[bj][n] = *(const f32x4*)(gp + bj * HALF + 4 * n);
#pragma unroll
            for (int ai = 0; ai < 2; ++ai)
#pragma unroll
                for (int mh = 0; mh < 2; ++mh) {
                    f32x4 x0[2][2], x1[2][2];
#pragma unroll
                    for (int mm = 0; mm < 2; ++mm) { const int m = 2 * mh + mm; const size_t ro = (size_t)(row0 + ai * HALF + m * 16) * D + col0;
#pragma unroll
                        for (int bj = 0; bj < 2; ++bj) {
                            if (IN_F32) { x0[mm][bj] = *(const f32x4*)(xin32 + ro + bj * HALF); x1[mm][bj] = *(const f32x4*)(xin32 + ro + bj * HALF + 4); }
                            else { const u32x4 xw = *(const u32x4*)(xb + ro + bj * HALF);
                                x0[mm][bj] = (f32x4){__uint_as_float(xw.x << 16), __uint_as_float(xw.x & 0xFFFF0000u), __uint_as_float(xw.y << 16), __uint_as_float(xw.y & 0xFFFF0000u)};
                                x1[mm][bj] = (f32x4){__uint_as_float(xw.z << 16), __uint_as_float(xw.z & 0xFFFF0000u), __uint_as_float(xw.w << 16), __uint_as_float(xw.w & 0xFFFF0000u)}; } } }
                    __builtin_amdgcn_sched_barrier(0);
#pragma unroll
                    for (int mm = 0; mm < 2; ++mm) { const int m = 2 * mh + mm; const size_t ro = (size_t)(row0 + ai * HALF + m * 16) * D + col0;
#pragma unroll
                        for (int bj = 0; bj < 2; ++bj) {
                            const f32x4 v0 = x0[mm][bj] + gv[bj][0] * acc[ai][bj][m][0], v1 = x1[mm][bj] + gv[bj][1] * acc[ai][bj][m][1];
                            u32x4 w; w.x = cvt_pk_bf16(v0[0], v0[1]); w.y = cvt_pk_bf16(v0[2], v0[3]); w.z = cvt_pk_bf16(v1[0], v1[1]); w.w = cvt_pk_bf16(v1[2], v1[3]);
                            *(u32x4*)(xb + ro + bj * HALF) = w;
                            acc[ai][bj][m][0] = (f32x4){__uint_as_float(w.x << 16), __uint_as_float(w.x & 0xFFFF0000u), __uint_as_float(w.y << 16), __uint_as_float(w.y & 0xFFFF0000u)};
                            acc[ai][bj][m][1] = (f32x4){__uint_as_float(w.z << 16), __uint_as_float(w.z & 0xFFFF0000u), __uint_as_float(w.w << 16), __uint_as_float(w.w & 0xFFFF0000u)}; } }
                    __builtin_amdgcn_sched_barrier(0);
                }
        }
#pragma unroll
        for (int ai = 0; ai < 2; ++ai)
#pragma unroll
            for (int m = 0; m < 4; ++m) { float sq = 0.f;
#pragma unroll
                for (int bj = 0; bj < 2; ++bj)
#pragma unroll
                    for (int n = 0; n < 2; ++n) { const f32x4 x = acc[ai][bj][m][n]; sq += (x[0] * x[0] + x[1] * x[1]) + (x[2] * x[2] + x[3] * x[3]); }
                sq = rows_sum(sq);
                if (fq == 0) P[(ai * HALF + wr * 64 + m * 16 + fr) * 4 + wc] = sq; }
        asm volatile("s_waitcnt lgkmcnt(0)" ::: "memory"); __builtin_amdgcn_s_barrier(); asm volatile("" ::: "memory");
        const int row = wid * 32 + (lane & 31);
        unsigned* srow = slots + ((size_t)u.pm * BM + row) * 8;
        if (lane < 32) { const f32x4 p4 = *(const LAS f32x4*)(P + row * 4);
            __hip_atomic_store(srow + u.pn, __float_as_uint((p4[0] + p4[1]) + (p4[2] + p4[3])), __ATOMIC_RELAXED, __HIP_MEMORY_SCOPE_AGENT); }
        asm volatile("s_waitcnt vmcnt(0)" ::: "memory");
        if (lane == 0) (void)__hip_atomic_fetch_add(cnt + 64 * u.pm, 1u, __ATOMIC_RELAXED, __HIP_MEMORY_SCOPE_AGENT);
        f32x4 gam[2][2], shv[2][2];
#pragma unroll
        for (int bj = 0; bj < 2; ++bj)
#pragma unroll
            for (int n = 0; n < 2; ++n) { const int col = col0 + bj * HALF + 4 * n; const float* mb = modb + (size_t)bb * 12288;
                gam[bj][n] = *(const f32x4*)(g + col) * (1.0f + *(const f32x4*)(mb + sc_off + col)); shv[bj][n] = *(const f32x4*)(mb + sh_off + col); }
        if (wid == 0) { unsigned sp = 0;
            while ((unsigned)__builtin_amdgcn_readfirstlane(__hip_atomic_load(cnt + 64 * u.pm, __ATOMIC_RELAXED, __HIP_MEMORY_SCOPE_AGENT)) < 64u) {
                __builtin_amdgcn_s_sleep(1);
                if ((++sp & 255u) == 0u) { if (__hip_atomic_load(tmo, __ATOMIC_RELAXED, __HIP_MEMORY_SCOPE_AGENT)) break; if (sp > XB_SPIN_CAP) { if (lane == 0) atomicAdd(tmo, 1u); break; } } }
            __builtin_amdgcn_fence(__ATOMIC_ACQUIRE, "agent");
            asm volatile("s_waitcnt vmcnt(0)" ::: "memory"); }
        asm volatile("" ::: "memory"); __builtin_amdgcn_s_barrier(); asm volatile("" ::: "memory");
        if (lane < 32) { float tot = 0.f;
#pragma unroll
            for (int t = 0; t < 8; ++t) tot += __uint_as_float(__hip_atomic_load(srow + t, __ATOMIC_RELAXED, __HIP_MEMORY_SCOPE_AGENT));
            S[row] = rsqrtf(tot * (1.0f / D) + EPS); }
        asm volatile("s_waitcnt vmcnt(0) lgkmcnt(0)" ::: "memory"); __builtin_amdgcn_s_barrier(); asm volatile("" ::: "memory");
#pragma unroll
        for (int ai = 0; ai < 2; ++ai)
#pragma unroll
            for (int m = 0; m < 4; ++m) { const float rstd = S[ai * HALF + wr * 64 + m * 16 + fr]; const size_t ro = (size_t)(row0 + ai * HALF + m * 16) * D + col0;
#pragma unroll
                for (int bj = 0; bj < 2; ++bj) { const f32x4 h0 = acc[ai][bj][m][0] * rstd * gam[bj][0] + shv[bj][0], h1 = acc[ai][bj][m][1] * rstd * gam[bj][1] + shv[bj][1];
                    u32x2 w8; w8.x = pk4_fp8(h0[0], h0[1], h0[2], h0[3]); w8.y = pk4_fp8(h1[0], h1[1], h1[2], h1[3]);
                    *(u32x2*)(h8 + ro + bj * HALF) = w8;
                    if (OUT16) { u32x4 w; w.x = cvt_pk_bf16(h0[0], h0[1]); w.y = cvt_pk_bf16(h0[2], h0[3]); w.z = cvt_pk_bf16(h1[0], h1[1]); w.w = cvt_pk_bf16(h1[2], h1[3]); *(u32x4*)(h16 + ro + bj * HALF) = w; } } }
    }
};
template <bool SIG>
struct EpiSwiglu {
    static constexpr bool PERM = true, AFTER_DRAIN = false;
    us* O; int ldc; unsigned* cnt; unsigned long long emlo; unsigned emhi;
    __device__ __forceinline__ u32x2 row8(const Acc& acc, int ai, int m) const {
        f32x4 r0, r1;
#pragma unroll
        for (int j = 0; j < 4; ++j) { const float g0 = acc[ai][0][m][0][j], g1 = acc[ai][0][m][1][j];
            r0[j] = g0 * __builtin_amdgcn_rcpf(1.0f + __expf(-g0)) * acc[ai][1][m][0][j]; r1[j] = g1 * __builtin_amdgcn_rcpf(1.0f + __expf(-g1)) * acc[ai][1][m][1][j]; }
        u32x2 w; w.x = pk4_fp8(r0[0], r0[1], r0[2], r0[3]); w.y = pk4_fp8(r1[0], r1[1], r1[2], r1[3]); return w;
    }
    __device__ __forceinline__ void operator()(const Acc& acc, const Unit& u, int wr, int wc, int fr, int fq) const {
        const int row0 = u.pm * BM + wr * 64 + fr;
        if (!SIG) {
            const int col0 = u.pn * HALF + wc * 32 + 8 * fq;
#pragma unroll
            for (int ai = 0; ai < 2; ++ai)
#pragma unroll
                for (int m = 0; m < 4; ++m) *(u32x2*)((unsigned char*)O + (size_t)(row0 + ai * HALF + m * 16) * ldc + col0) = row8(acc, ai, m);
        } else {
            const bool early = u.pm < 64 ? ((emlo >> u.pm) & 1ull) != 0ull : ((emhi >> (u.pm & 31)) & 1u) != 0u;
            const int col0 = u.pn * HALF + wc * 32 + 16 * (fq >> 1);
#pragma unroll
            for (int ai = 0; ai < 2; ++ai)
#pragma unroll
                for (int mp = 0; mp < 2; ++mp) { const u32x2 w0 = row8(acc, ai, 2 * mp), w1 = row8(acc, ai, 2 * mp + 1);
                    const auto sx = __builtin_amdgcn_permlane16_swap(w0.x, w1.x, false, false), sy = __builtin_amdgcn_permlane16_swap(w0.y, w1.y, false, false);
                    u32x4 w; w.x = sx[0]; w.y = sy[0]; w.z = sx[1]; w.w = sy[1];
                    unsigned char* rowp = (unsigned char*)O + (size_t)(row0 + ai * HALF + (2 * mp + (fq & 1)) * 16) * ldc + col0;
                    if (early) asm volatile("global_store_dwordx4 %0, %1, off sc1\n\ts_nop 1" :: "v"(rowp), "v"(w) : "memory");
                    else *(u32x4*)rowp = w; }
            if (early) { asm volatile("s_waitcnt vmcnt(0)" ::: "memory");
                if (fr == 0 && fq == 0) (void)__hip_atomic_fetch_add(moe_cnt(cnt, u.pm), 1u, __ATOMIC_RELAXED, __HIP_MEMORY_SCOPE_AGENT); }
        }
    }
};
}

struct Args {
    const float* in[25];
    float* out;
    unsigned char* ws;
    int lo, hi;
    int use_bar; int pad_;
};
enum { I_X = 0, I_C, I_POS, I_ADAW, I_ADAB, I_N1G, I_N2G, I_WIN, I_QNG, I_KVNG, I_WUQ, I_WUKV, I_GWG, I_GBG, I_GNG, I_WOUT, I_FWG, I_FWU, I_FWD,
       I_RW, I_RB, I_MWG, I_MWU, I_MWD, I_FNG };

struct Ctx {
    LAS unsigned char* lds; int tid, lane, wave, G, bid;
};

struct CvtJob { const float* src; us* dst; const float* kscale; int K, N, map, tk, tn, fp8; };
__device__ __forceinline__ int cvt_row(int map, int n) {
    if (map == 0) return n;
    if (map == 1) return (n >> 7) * 256 + (n & 127);
    if (map == 2) return (n >> 7) * 256 + 128 + (n & 127);
    if (map == 3) { const int h = n / 192, j = n % 192; if (j < 128) return n; const int r = j - 128; return h * 192 + 128 + (r < 32 ? 2 * r : 2 * (r - 32) + 1); }
    if (map == 4) { const int h = n >> 8, j = n & 255; return j < 128 ? h * 128 + j : 512 + h * 128 + (j - 128); }
    int col;
    if (n < 512) col = C_CQ + n; else if (n < 768) col = C_CKV + (n - 512); else if (n < 832) col = C_KPE + (n - 768); else if (n < 1344) col = C_GQ + (n - 832);
    else if (n < 1856) col = C_GK + (n - 1344); else if (n < 2880) col = C_GV + (n - 1856); else if (n < 2896) col = C_GLOW + (n - 2880); else if (n < 3920) col = C_GR + (n - 2896); else col = n;
    if (map == 5) return col >= NP8 ? col - NP8 : -1;
    return col < NP8 ? col : -1;
}
constexpr int CT_WIN = 8 * 42,
               CT_WUQ = 2 * 6, CT_WUKV = 1 * 8, CT_WOUT = 8 * 16, CT_FGU = 8 * 44, CT_FD = 22 * 16, CT_MGU = 8 * 22, CT_MD = 11 * 16;
constexpr int CVT_TILES = 2 * CT_WIN + 2 * CT_WUQ + 2 * CT_WUKV + 2 * CT_WOUT + 2 * CT_FGU + CT_FD + 16 * CT_MGU + 8 * CT_MD;
constexpr int MOD_ITEMS = 192, CS_ITEMS = 512;

__device__ __forceinline__ void cvt_decode(int t, const Args& a, CvtJob& j) {
    unsigned char* ws = a.ws;
    int ntn;
    j.fp8 = 0;
    if (t < 2 * CT_WIN) { const int l = t / CT_WIN; t %= CT_WIN; j.src = a.in[I_WIN] + (size_t)l * D * DPROJ; j.kscale = nullptr; j.K = D; j.N = DPROJ;
        const int tk = t / 42, tt = t % 42;
        if (tt < 6) { j.dst = (us*)(ws + WS_WIN) + (size_t)l * (DPROJ_P - NP8) * D; j.map = 5; j.tn = 36 + tt; }
        else { j.dst = (us*)(ws + WS_WIN8 + (size_t)l * NP8 * D); j.map = 6; j.fp8 = 1; j.tn = tt - 6; }
        j.tk = tk; return; }
    else if ((t -= 2 * CT_WIN) < 2 * CT_WUQ) { const int l = t / CT_WUQ; t %= CT_WUQ; j.src = a.in[I_WUQ] + (size_t)l * 512 * 768; j.dst = (us*)(ws + WS_WUQ) + (size_t)l * 768 * 512; j.kscale = a.in[I_QNG] + l * 512; j.K = 512; j.N = 768; j.map = 3; ntn = 6; }
    else if ((t -= 2 * CT_WUQ) < 2 * CT_WUKV) { const int l = t / CT_WUKV; t %= CT_WUKV; j.src = a.in[I_WUKV] + (size_t)l * 256 * 1024; j.dst = (us*)(ws + WS_WUKV) + (size_t)l * 1024 * 256; j.kscale = a.in[I_KVNG] + l * 256; j.K = 256; j.N = 1024; j.map = 4; ntn = 8; }
    else if ((t -= 2 * CT_WUKV) < 2 * CT_WOUT) { const int l = t / CT_WOUT; t %= CT_WOUT; j.src = a.in[I_WOUT] + (size_t)l * D * D; j.dst = (us*)((unsigned char*)(ws + WS_WOUT) + (size_t)l * D * D); j.kscale = nullptr; j.K = D; j.N = D; j.map = 0; ntn = 16; j.fp8 = 1; }
    else if ((t -= 2 * CT_WOUT) < 2 * CT_FGU) { const int w = t / CT_FGU; t %= CT_FGU; j.src = a.in[w ? I_FWU : I_FWG]; j.dst = (us*)(ws + WS_WGU); j.kscale = nullptr; j.K = D; j.N = DFF; j.map = 1 + w; ntn = 44; j.fp8 = 1; }
    else if ((t -= 2 * CT_FGU) < CT_FD) { j.src = a.in[I_FWD]; j.dst = (us*)(ws + WS_WD); j.kscale = nullptr; j.K = DFF; j.N = D; j.map = 0; ntn = 16; j.fp8 = 1; }
    else if ((t -= CT_FD) < 16 * CT_MGU) { const int w = t / (8 * CT_MGU); t %= 8 * CT_MGU; const int e = t / CT_MGU; t %= CT_MGU;
        j.src = a.in[w ? I_MWU : I_MWG] + (size_t)e * D * DFFE; j.dst = (us*)((unsigned char*)(ws + WS_MGU) + (size_t)e * 2 * DFFE * D); j.kscale = nullptr; j.K = D; j.N = DFFE; j.map = 1 + w; ntn = 22; j.fp8 = 1; }
    else { t -= 16 * CT_MGU; const int e = t / CT_MD; t %= CT_MD; j.src = a.in[I_MWD] + (size_t)e * DFFE * D; j.dst = (us*)((unsigned char*)(ws + WS_MD) + (size_t)e * D * DFFE); j.kscale = nullptr; j.K = DFFE; j.N = D; j.map = 0; ntn = 16; j.fp8 = 1; }
    j.tk = t / ntn; j.tn = t % ntn;
}

struct CvtRegs { f32x4 r[16]; float sc[16]; };
__device__ __forceinline__ void cvt_load(const Ctx& c, const CvtJob& j, CvtRegs& R) {
    const int k0 = j.tk * 256, n0 = j.tn * 128;
    if (j.fp8) {
#pragma unroll
        for (int it = 0; it < 4; ++it) { const int idx = it * 512 + c.tid, kq = idx >> 5, nq = idx & 31; const float* p = j.src + (size_t)(k0 + 4 * kq) * j.N + n0 + 4 * nq;
#pragma unroll
            for (int u = 0; u < 4; ++u) R.r[4 * it + u] = (n0 + 4 * nq < j.N) ? __builtin_nontemporal_load((const f32x4*)(p + (size_t)u * j.N)) : (f32x4){0.f, 0.f, 0.f, 0.f}; }
        return;
    }
#pragma unroll
    for (int it = 0; it < 8; ++it) {
        const int idx = it * 512 + c.tid, kp = idx >> 5, nq = idx & 31, n = n0 + 4 * nq, k = k0 + 2 * kp;
        R.r[2 * it] = (f32x4){0.f, 0.f, 0.f, 0.f}; R.r[2 * it + 1] = R.r[2 * it];
        if (n < j.N) { R.r[2 * it] = __builtin_nontemporal_load((const f32x4*)(j.src + (size_t)k * j.N + n)); R.r[2 * it + 1] = __builtin_nontemporal_load((const f32x4*)(j.src + (size_t)(k + 1) * j.N + n)); }
        R.sc[2 * it] = 1.f; R.sc[2 * it + 1] = 1.f;
        if (j.kscale) { R.sc[2 * it] = j.kscale[k]; R.sc[2 * it + 1] = j.kscale[k + 1]; }
    }
}
__device__ __forceinline__ void cvt_store(const Ctx& c, const CvtJob& j, const CvtRegs& R) {
    LAS unsigned* W = (LAS unsigned*)c.lds;
    const int k0 = j.tk * 256, n0 = j.tn * 128;
    if (j.fp8) {
#pragma unroll
        for (int it = 0; it < 4; ++it) { const int idx = it * 512 + c.tid, kq = idx >> 5, nq = idx & 31, rp = (kq & 3) * 16 + (kq >> 2);
#pragma unroll
            for (int q = 0; q < 4; ++q) W[rp * 129 + q * 32 + nq] = pk4_fp8(R.r[4 * it][q] * 64.f, R.r[4 * it + 1][q] * 64.f, R.r[4 * it + 2][q] * 64.f, R.r[4 * it + 3][q] * 64.f); }
        __syncthreads();
        const int a16 = c.tid & 15, rsel = (c.tid >> 4) & 1, rest = c.tid >> 5;
#pragma unroll
        for (int ps = 0; ps < 4; ++ps) { const int nl = rsel * 64 + rest + 16 * ps, cp = (nl & 3) * 32 + (nl >> 2);
            u32x4 w; w.x = W[(0 * 16 + a16) * 129 + cp]; w.y = W[(1 * 16 + a16) * 129 + cp]; w.z = W[(2 * 16 + a16) * 129 + cp]; w.w = W[(3 * 16 + a16) * 129 + cp];
            const int n = n0 + nl; const int row = (n < j.N) ? cvt_row(j.map, n) : -1;
            if (row >= 0) *(u32x4*)((unsigned char*)j.dst + (size_t)row * j.K + k0 + 16 * a16) = w; }
        __syncthreads();
        return;
    }
#pragma unroll
    for (int it = 0; it < 8; ++it) {
        const int idx = it * 512 + c.tid, kp = idx >> 5, nq = idx & 31;
        const f32x4 r0 = R.r[2 * it] * R.sc[2 * it], r1 = R.r[2 * it + 1] * R.sc[2 * it + 1];
        const int rp = (kp & 3) * 32 + (kp >> 2);
#pragma unroll
        for (int q = 0; q < 4; ++q) W[rp * 128 + q * 32 + nq] = pk2(r0[q], r1[q]);
    }
    __syncthreads();
    const int a = c.tid & 31, nn = c.tid >> 5;
#pragma unroll
    for (int it = 0; it < 8; ++it) {
        const int nl = nn + 16 * it, n = n0 + nl, cp = (nl & 3) * 32 + (nl >> 2);
        u32x4 w;
        w.x = W[(0 * 32 + a) * 128 + cp]; w.y = W[(1 * 32 + a) * 128 + cp]; w.z = W[(2 * 32 + a) * 128 + cp]; w.w = W[(3 * 32 + a) * 128 + cp];
        int row = -1;
        if (n < j.N) row = cvt_row(j.map, n); else if (j.map == 5 && n < DPROJ_P) row = n - NP8;
        if (row >= 0) *(u32x4*)(j.dst + (size_t)row * j.K + k0 + 8 * a) = w;
    }
    __syncthreads();
}

__device__ __forceinline__ void mod_item(const Ctx& c, const Args& a, int item) {
    LAS float* ca = (LAS float*)c.lds;
    LAS float* red = (LAS float*)(c.lds + 32768);
    for (int i = c.tid; i < 4 * 2048; i += 512) ca[i] = siluf(a.in[I_C][i]);
    __syncthreads();
    const int l = item / 96, cb = item % 96, nq = c.tid & 31, kg = c.tid >> 5;
    const float* w = a.in[I_ADAW] + (size_t)l * D * 12288 + cb * 128 + 4 * nq;
    f32x4 acc[4];
#pragma unroll
    for (int b = 0; b < 4; ++b) acc[b] = (f32x4){0.f, 0.f, 0.f, 0.f};
#pragma unroll 1
    for (int kk = 0; kk < 128; kk += 16) {
        f32x4 wv[16];
#pragma unroll
        for (int u = 0; u < 16; ++u) wv[u] = __builtin_nontemporal_load((const f32x4*)(w + (size_t)(kg * 128 + kk + u) * 12288));
#pragma unroll
        for (int u = 0; u < 16; ++u)
#pragma unroll
            for (int b = 0; b < 4; ++b) acc[b] += wv[u] * ca[b * 2048 + kg * 128 + kk + u];
    }
#pragma unroll
    for (int b = 0; b < 4; ++b)
#pragma unroll
        for (int q = 0; q < 4; ++q) red[(kg * 4 + b) * 128 + 4 * nq + q] = acc[b][q];
    __syncthreads();
    { const int b = c.tid >> 7, col = c.tid & 127; float s = a.in[I_ADAB][l * 12288 + cb * 128 + col];
#pragma unroll
      for (int g = 0; g < 16; ++g) s += red[(g * 4 + b) * 128 + col];
      __hip_atomic_store((float*)(a.ws + WS_MOD) + ((size_t)l * 4 + b) * 12288 + cb * 128 + col, s, __ATOMIC_RELAXED, __HIP_MEMORY_SCOPE_AGENT); }
    asm volatile("s_waitcnt vmcnt(0)" ::: "memory");
    __syncthreads();
    if (l == 0 && c.tid == 0) (void)__hip_atomic_fetch_add((unsigned*)(a.ws + WS_NCNT) + 48, 1u, __ATOMIC_RELAXED, __HIP_MEMORY_SCOPE_AGENT);
}

__device__ __forceinline__ void cs_item(const Ctx& c, const Args& a, int item) {
    const int tok = item * 16 + (c.tid >> 5), i = c.tid & 31;
    const float pos = (float)((const int*)a.in[I_POS])[tok];
    const float inv = exp2f(-(float)i * (13.287712379549449f / 32.0f));
    const float ang = pos * inv;
    const double rev = (double)ang * 0.15915494309189535;
    const float fr = (float)(rev - rint(rev));
    float sn, cn;
    sn = __builtin_amdgcn_sinf(fr); cn = __builtin_amdgcn_cosf(fr);
    *(f32x2*)(a.ws + WS_CS + ((size_t)tok * 32 + i) * 8) = (f32x2){cn, sn};
}

constexpr int CVT_DEFER = 0, CVT_DEFER_UP = 512;
#ifndef PRO_REPS
#define PRO_REPS 1
#endif
__device__ __forceinline__ void cvt_range(const Ctx& c, const Args& a, int t0, int t1r, int first, int nb, int reps = 1) {
    int t = t0 + (c.bid - first); const int span = t1r - t0, t1 = t0 + span * reps;
    if (c.bid >= first && c.bid < first + nb && t < t1) {
        CvtJob jc; CvtRegs Rc; cvt_decode(t0 + (t - t0) % span, a, jc); cvt_load(c, jc, Rc);
#pragma unroll 1
        for (;;) {
            const int tn = t + nb; const bool more = tn < t1;
            CvtJob jn = jc; CvtRegs Rn;
            if (more) { cvt_decode(t0 + (tn - t0) % span, a, jn); cvt_load(c, jn, Rn); }
            cvt_store(c, jc, Rc);
            if (!more) break;
            jc = jn; t = tn;
#pragma unroll
            for (int i = 0; i < 16; ++i) { Rc.r[i] = Rn.r[i]; Rc.sc[i] = Rn.sc[i]; }
        }
    }
}
__device__ __forceinline__ void prologue_phase(const Ctx& c, const Args& a) {
    for (int itr = c.bid; itr < (MOD_ITEMS + CS_ITEMS) * PRO_REPS; itr += c.G) { const int it = itr % (MOD_ITEMS + CS_ITEMS);
        if (it < MOD_ITEMS) mod_item(c, a, it); else cs_item(c, a, it - MOD_ITEMS);
    }
    if (c.G == 256) {
        cvt_range(c, a, 0, 384, 192, 64, PRO_REPS);
        cvt_range(c, a, 384, CVT_TILES - 2 * CVT_DEFER - CVT_DEFER_UP, 0, 256, PRO_REPS);
    } else cvt_range(c, a, 0, CVT_TILES, 0, c.G);
}

template <bool XBF16> __device__ __forceinline__ f32x4 ldx4(const float* x, size_t idx) {
    if (!XBF16) return *(const f32x4*)(x + idx);
    const u32x2 w = *(const u32x2*)((const us*)x + idx);
    return (f32x4){__uint_as_float(w.x << 16), __uint_as_float(w.x & 0xFFFF0000u), __uint_as_float(w.y << 16), __uint_as_float(w.y & 0xFFFF0000u)};
}
template <bool ROUTER, int FP8OUT  , bool XBF16>
__device__ __forceinline__ void norm_phase(const Ctx& c, const Args& a, const float* x, const float* g, const float* mod_l, int sh_off, int sc_off, us* h, unsigned char* h8 = nullptr) {
    LAS float* rwT = (LAS float*)c.lds;
    if (ROUTER) { for (int i = c.tid; i < 8 * 2048; i += 512) rwT[(i & 7) * 2048 + (i >> 3)] = a.in[I_RW][i]; __syncthreads(); }
    for (int rg = c.bid * 8 + c.wave; rg < NTOK / 4; rg += c.G * 8) {
        const int row0 = rg * 4, b = row0 >> 11;
        const float* mb = mod_l + (size_t)b * 12288;
        f32x4 gam[8], shv[8], v[8], vn[8];
#pragma unroll
        for (int i = 0; i < 8; ++i) { const int col = (i * 64 + c.lane) * 4; gam[i] = *(const f32x4*)(g + col) * (1.0f + *(const f32x4*)(mb + sc_off + col)); shv[i] = *(const f32x4*)(mb + sh_off + col);
            v[i] = ldx4<XBF16>(x, (size_t)row0 * D + col); }
#pragma unroll
        for (int k = 0; k < 4; ++k) {
            const int row = row0 + k;
            if (k < 3) {
#pragma unroll
                for (int i = 0; i < 8; ++i) vn[i] = ldx4<XBF16>(x, (size_t)(row + 1) * D + (i * 64 + c.lane) * 4);
            }
            float ss = 0.f;
#pragma unroll
            for (int i = 0; i < 8; ++i) ss += v[i][0] * v[i][0] + v[i][1] * v[i][1] + v[i][2] * v[i][2] + v[i][3] * v[i][3];
            ss = wave_sum(ss);
            const float rstd = rsqrtf(ss * (1.0f / D) + EPS);
            float lg[8];
            if (ROUTER) {
#pragma unroll
                for (int e = 0; e < 8; ++e) lg[e] = 0.f;
            }
#pragma unroll
            for (int i = 0; i < 8; ++i) { const int col = (i * 64 + c.lane) * 4;
                const f32x4 hv = v[i] * rstd * gam[i] + shv[i];
                if (FP8OUT == 1) *(unsigned*)((unsigned char*)h + (size_t)row * D + col) = pk4_fp8(hv[0], hv[1], hv[2], hv[3]);
                if (FP8OUT == 2) *(unsigned*)(h8 + (size_t)row * D + col) = pk4_fp8(hv[0], hv[1], hv[2], hv[3]);
                if (FP8OUT != 1) { u32x2 w; w.x = pg8::cvt_pk_bf16(hv[0], hv[1]); w.y = pg8::cvt_pk_bf16(hv[2], hv[3]); *(u32x2*)(h + (size_t)row * D + col) = w; }
                if (ROUTER) {
#pragma unroll
                    for (int e = 0; e < 8; ++e) { const f32x4 r = *(const LAS f32x4*)(rwT + e * 2048 + col); lg[e] += hv[0] * r[0] + hv[1] * r[1] + hv[2] * r[2] + hv[3] * r[3]; }
                    __builtin_amdgcn_sched_barrier(0);
                }
            }
            if (ROUTER) {
#pragma unroll
                for (int e = 0; e < 8; ++e) lg[e] = wave_sum(lg[e]) + a.in[I_RB][e];
                int e0 = 0; float v0 = lg[0];
#pragma unroll
                for (int e = 1; e < 8; ++e) if (lg[e] > v0) { v0 = lg[e]; e0 = e; }
                int e1 = -1; float v1 = -3.0e38f;
#pragma unroll
                for (int e = 0; e < 8; ++e) if (e != e0 && lg[e] > v1) { v1 = lg[e]; e1 = e; }
                const float w1 = 1.0f / (1.0f + __expf(v0 - v1)), w0 = 1.0f - w1;
                if (c.lane == 0) { int* rt = (int*)(a.ws + WS_ROUTE); rt[row] = e0; rt[NTOK + row] = e1; ((float*)rt)[2 * NTOK + row] = w0; ((float*)rt)[3 * NTOK + row] = w1; }
            }
            if (k < 3) {
#pragma unroll
                for (int i = 0; i < 8; ++i) v[i] = vn[i];
            }
        }
    }
    if (ROUTER) __syncthreads();
}

__device__ __forceinline__ void rowstats_job(const Ctx& c, const Args& a) {
    const us* proj = (const us*)(a.ws + WS_PROJ); float* rs = (float*)(a.ws + WS_RSTD); us* kpe = (us*)(a.ws + WS_KPE);
    for (int tok = c.bid * 8 + c.wave; tok < NTOK; tok += c.G * 8) {
        const us* pr = proj + (size_t)tok * DPROJ_P;
        const bf16x8 q8 = ld8(pr + C_CQ + 8 * c.lane);
        float sq = 0.f, skv = 0.f;
#pragma unroll
        for (int j = 0; j < 8; ++j) { const float f = bf2f((us)q8[j]); sq += f * f; }
        if (c.lane < 32) { const bf16x8 k8 = ld8(pr + C_CKV + 8 * c.lane);
#pragma unroll
            for (int j = 0; j < 8; ++j) { const float f = bf2f((us)k8[j]); skv += f * f; } }
        sq = wave_sum(sq); skv = wave_sum(skv);
        if (c.lane == 0) { rs[tok] = rsqrtf(sq * (1.0f / 512.0f) + EPS); rs[NTOK + tok] = rsqrtf(skv * (1.0f / 256.0f) + EPS); }
        if (c.lane < 32) { const float x1 = bf2f(pr[C_KPE + c.lane]), x2 = bf2f(pr[C_KPE + 32 + c.lane]);
            const f32x2 cs = *(const f32x2*)(a.ws + WS_CS + ((size_t)tok * 32 + c.lane) * 8);
            *(unsigned*)(kpe + (size_t)tok * 64 + 2 * c.lane) = pk2(x1 * cs[0] - x2 * cs[1], x1 * cs[1] + x2 * cs[0]); }
    }
}
__device__ __forceinline__ void dvt_job(const Ctx& c, const Args& a) {
    const us* proj = (const us*)(a.ws + WS_PROJ); us* dvt = (us*)(a.ws + WS_DVT);
    for (int item = c.bid; item < 128; item += c.G) {
        const int b = item >> 5, t0 = (item & 31) * 64, d = c.tid & 127, tq = c.tid >> 7;
        unsigned w[8];
#pragma unroll
        for (int i = 0; i < 8; ++i) { const size_t r = (size_t)(b * SEQ + t0 + tq * 16 + 2 * i) * DPROJ_P + C_DV + d; w[i] = (unsigned)proj[r] | ((unsigned)proj[r + DPROJ_P] << 16); }
        us* dp = dvt + ((size_t)b * 128 + d) * SEQ + t0 + tq * 16;
        *(u32x4*)dp = (u32x4){w[0], w[1], w[2], w[3]}; *(u32x4*)(dp + 8) = (u32x4){w[4], w[5], w[6], w[7]};
    }
}
__device__ __forceinline__ void gla_a_job(const Ctx& c, const Args& a, int l) {
    const us* proj = (const us*)(a.ws + WS_PROJ);
    LAS us* kd = (LAS us*)c.lds;
    LAS us* vt = (LAS us*)(c.lds + 128 * 144);
    LAS float* gl = (LAS float*)(c.lds + 384 * 144);
    LAS float* part = (LAS float*)(c.lds + 384 * 144 + 4096);
    LAS us* kraw = (LAS us*)(c.lds + 65536);
    const float* wg = a.in[I_GWG] + (size_t)l * 16 * 512; const float* bg = a.in[I_GBG] + l * 512;
    const int k = c.tid & 127, tg = c.tid >> 7;
    us glr[2]; float w[16]; float bb = 0.f; u32x4 kc[2], vc[4];
#define GLA_LOAD(IT) do { const int it_ = (IT), h_ = it_ & 3; const size_t tok_ = (size_t)(it_ >> 7) * SEQ + ((it_ >> 2) & 31) * 64; \
        _Pragma("unroll") for (int i = 0; i < 2; ++i) { const int ii = c.tid + 512 * i; glr[i] = proj[(tok_ + (ii >> 4)) * DPROJ_P + C_GLOW + (ii & 15)]; } \
        _Pragma("unroll") for (int r = 0; r < 16; ++r) w[r] = wg[r * 512 + h_ * 128 + k]; \
        bb = bg[h_ * 128 + k]; \
        _Pragma("unroll") for (int i = 0; i < 2; ++i) { const int id = c.tid + 512 * i; kc[i] = *(const u32x4*)(proj + (tok_ + (id >> 4)) * DPROJ_P + C_GK + h_ * 128 + 8 * (id & 15)); } \
        _Pragma("unroll") for (int i = 0; i < 4; ++i) vc[i] = *(const u32x4*)(proj + (tok_ + c.lane) * DPROJ_P + C_GV + h_ * 256 + 8 * (c.wave + 8 * i)); } while (0)
    if (c.bid < 512) GLA_LOAD(c.bid);
    for (int item = c.bid; item < 512; item += c.G) {
        const int b = item >> 7, n = (item >> 2) & 31, h = item & 3; const size_t tok0 = (size_t)b * SEQ + n * 64;
        gl[c.tid] = bf2f(glr[0]); gl[c.tid + 512] = bf2f(glr[1]);
        __syncthreads();
        float la[16]; float run = 0.f;
#pragma unroll
        for (int tt = 0; tt < 16; ++tt) { const int t = tg * 16 + tt; float z = bb;
#pragma unroll
            for (int r = 0; r < 16; ++r) z += gl[t * 16 + r] * w[r];
            const float ls = fminf(z, 0.f) - __logf(1.0f + __expf(-fabsf(z)));
            run += ls * (1.0f / 16.0f); la[tt] = run; }
        part[tg * 128 + k] = run;
#pragma unroll
        for (int i = 0; i < 4; ++i) { const int v0 = 8 * (c.wave + 8 * i); const unsigned wv[4] = {vc[i].x, vc[i].y, vc[i].z, vc[i].w};
#pragma unroll
            for (int j = 0; j < 4; ++j) { vt[(v0 + 2 * j) * 72 + c.lane] = (us)(wv[j] & 0xFFFFu); vt[(v0 + 2 * j + 1) * 72 + c.lane] = (us)(wv[j] >> 16); } }
#pragma unroll
        for (int i = 0; i < 2; ++i) { const int id = c.tid + 512 * i; *(LAS u32x4*)(kraw + (id >> 4) * 136 + 8 * (id & 15)) = kc[i]; }
        __syncthreads();
        {   const float p0 = part[k], p1 = part[128 + k], p2 = part[256 + k], p3 = part[384 + k];
            const float total = (p0 + p1) + (p2 + p3);
            const float pre = (tg > 0 ? p0 : 0.f) + (tg > 1 ? p1 : 0.f) + (tg > 2 ? p2 : 0.f);
            if (tg == 0) ((float*)(a.ws + WS_DEC))[(size_t)item * 128 + k] = __expf(total);
#pragma unroll
            for (int tt = 0; tt < 16; ++tt) kd[k * 72 + tg * 16 + tt] = f2bf(bf2f(kraw[(tg * 16 + tt) * 136 + k]) * __expf(total - (pre + la[tt])));
        }
        __syncthreads();
        if (item + c.G < 512) GLA_LOAD(item + c.G);
        {
            const int fr = c.lane & 15, g = c.lane >> 4;
            f32x4 acc[8][2];
#pragma unroll
            for (int kb = 0; kb < 8; ++kb) { acc[kb][0] = (f32x4){0.f, 0.f, 0.f, 0.f}; acc[kb][1] = acc[kb][0]; }
#pragma unroll
            for (int ts = 0; ts < 2; ++ts) {
                bf16x8 bv[2];
#pragma unroll
                for (int vb = 0; vb < 2; ++vb) bv[vb] = *(const LAS bf16x8*)(vt + ((c.wave * 2 + vb) * 16 + fr) * 72 + ts * 32 + g * 8);
#pragma unroll
                for (int kb = 0; kb < 8; ++kb) { const bf16x8 av = *(const LAS bf16x8*)(kd + (kb * 16 + fr) * 72 + ts * 32 + g * 8);
                    acc[kb][0] = mfma16(av, bv[0], acc[kb][0]); acc[kb][1] = mfma16(av, bv[1], acc[kb][1]); }
            }
            us* out = (us*)(a.ws + WS_CKV) + (size_t)item * 256 * 128;
#pragma unroll
            for (int vb = 0; vb < 2; ++vb)
#pragma unroll
                for (int kb = 0; kb < 8; ++kb) { u32x2 w; w.x = pk2(acc[kb][vb][0], acc[kb][vb][1]); w.y = pk2(acc[kb][vb][2], acc[kb][vb][3]);
                    *(u32x2*)(out + (size_t)((c.wave * 2 + vb) * 16 + fr) * 128 + kb * 16 + 4 * g) = w; }
        }
        __syncthreads();
    }
}
__device__ __forceinline__ int wave_sum_dpp(int v) {
    v += __builtin_amdgcn_update_dpp(0, v, 0xB1, 0xf, 0xf, false);
    v += __builtin_amdgcn_update_dpp(0, v, 0x4E, 0xf, 0xf, false);
    v += __builtin_amdgcn_update_dpp(0, v, 0x141, 0xf, 0xf, false);
    v += __builtin_amdgcn_update_dpp(0, v, 0x140, 0xf, 0xf, false);
    v += __builtin_amdgcn_update_dpp(0, v, 0x142, 0xa, 0xf, false);
    v += __builtin_amdgcn_update_dpp(0, v, 0x143, 0xc, 0xf, false);
    return __builtin_amdgcn_readlane(v, 63);
}
#undef GLA_LOAD
template <int NE>
__device__ __forceinline__ unsigned dsa_select(const LAS unsigned* scq, int lane, int ch) {
    unsigned e[NE];
#pragma unroll
    for (int i = 0; i < NE; ++i) e[i] = (i <= ch) ? scq[64 * i + lane] : 0u;
    unsigned prefix = 0u; bool exact = false;
#pragma unroll 1
    for (int bit = 31; bit >= 0; --bit) {
        const unsigned cand = prefix | (1u << bit); int cv = 0, cs = 0;
#pragma unroll
        for (int i = 0; i < NE / 2; ++i) cv += (e[i] >= cand) ? 1 : 0;
#pragma unroll
        for (int i = NE / 2; i < NE; ++i) { cs += __popcll(__ballot(e[i] >= cand)); if ((i & 7) == 7) __builtin_amdgcn_sched_barrier(0); }
        const int cnt = wave_sum_dpp(cv) + cs;
        if (cnt >= 256) prefix = cand;
        if (cnt == 256) { exact = true; break; }
    }
    const unsigned T = prefix;
    unsigned selw = 0u;
#pragma unroll
    for (int i = 0; i < NE; ++i) selw |= (e[i] >= T) ? (1u << i) : 0u;
    if (!exact) {
        int cgt = 0, cge = 0;
#pragma unroll
        for (int i = 0; i < NE; ++i) { cgt += (e[i] > T) ? 1 : 0; cge += (e[i] >= T) ? 1 : 0; }
        cgt = wave_sum_dpp(cgt); cge = wave_sum_dpp(cge);
        if (cge != 256) {
            int quota = 256 - cgt; selw = 0u;
#pragma unroll 1
            for (int i = 0; i <= ch; ++i) { const unsigned v = scq[64 * i + lane];
                const u64 eq = __ballot(v == T); const int rank = __popcll(eq & ((1ull << lane) - 1ull));
                const bool take = (v > T) || (v == T && rank < quota);
                selw |= take ? (1u << i) : 0u; const int ne = __popcll(eq); quota = quota > ne ? quota - ne : 0; }
        }
    }
    return selw;
}
__device__ __forceinline__ unsigned ord_u32(float f) { f = f + 0.0f; const unsigned u = __float_as_uint(f); return (u & 0x80000000u) ? ~u : (u | 0x80000000u); }
__device__ __forceinline__ void dsa_index_job(const Ctx& c, const Args& a) {
    const us* proj = (const us*)(a.ws + WS_PROJ); unsigned* mask = (unsigned*)(a.ws + WS_MASK);
    LAS unsigned* sc = (LAS unsigned*)c.lds;
    const int fr = c.lane & 15, g = c.lane >> 4;
    for (int it0 = c.bid; it0 < 512; it0 += c.G) {
        const int b = it0 >> 7, qg = ((it0 / c.G) & 1) ? 127 - (it0 & 127) : (it0 & 127), ch = qg >> 2;
        const size_t tq0 = (size_t)b * SEQ + qg * 16;
        if (ch <= 3) {
            for (int i = c.tid; i < 16 * 64; i += 512) mask[tq0 * 64 + i] = (2u << ch) - 1u;
            continue;
        }
        {
            const us* qr = proj + (tq0 + fr) * DPROJ_P;
            bf16x8 iq[8][2]; float iw[8];
#pragma unroll
            for (int hh = 0; hh < 8; ++hh) { iq[hh][0] = ld8(qr + C_IQ + hh * 64 + 8 * g); iq[hh][1] = ld8(qr + C_IQ + hh * 64 + 32 + 8 * g); }
            { const bf16x8 w8 = ld8(qr + C_IW);
#pragma unroll
              for (int hh = 0; hh < 8; ++hh) iw[hh] = bf2f((us)w8[hh]); }
            const int nkb = 4 * (ch + 1);
#define DSA_LOADK(K0, K1, J0) _Pragma("unroll") for (int u = 0; u < 4; ++u) { const int kbx = c.wave + 8 * ((J0) + u), kb = kbx < nkb ? kbx : c.wave;          \
                    const us* kr = proj + ((size_t)b * SEQ + kb * 16 + fr) * DPROJ_P + C_IK; K0[u] = ld8(kr + 8 * g); K1[u] = ld8(kr + 32 + 8 * g); }
#define DSA_SCORE(K0, K1, J0) _Pragma("unroll") for (int u = 0; u < 4; ++u) { const int kb = c.wave + 8 * ((J0) + u); \
                    if (kb < nkb) { f32x4 s = (f32x4){0.f, 0.f, 0.f, 0.f}; \
                        _Pragma("unroll") for (int hh = 0; hh < 8; ++hh) { f32x4 d = mfma16(K0[u], iq[hh][0], (f32x4){0.f, 0.f, 0.f, 0.f}); d = mfma16(K1[u], iq[hh][1], d); \
                            _Pragma("unroll") for (int r = 0; r < 4; ++r) s[r] += iw[hh] * fmaxf(d[r], 0.f); } \
                        *(LAS u32x4*)(sc + fr * 2052 + kb * 16 + 4 * g) = (u32x4){ord_u32(s[0]), ord_u32(s[1]), ord_u32(s[2]), ord_u32(s[3])}; } }
            JREP(8) {
                bf16x8 a0[4], a1[4], b0[4], b1[4];
                const int ng = (nkb - c.wave + 31) >> 5;
                DSA_LOADK(a0, a1, 0)
                if (ng > 1) { DSA_LOADK(b0, b1, 4) }
                __builtin_amdgcn_sched_barrier(0);
                DSA_SCORE(a0, a1, 0)
                __builtin_amdgcn_sched_barrier(0);
                if (ng > 2) { DSA_LOADK(a0, a1, 8) }
                __builtin_amdgcn_sched_barrier(0);
                if (ng > 1) { DSA_SCORE(b0, b1, 4) }
                __builtin_amdgcn_sched_barrier(0);
                if (ng > 3) { DSA_LOADK(b0, b1, 12) }
                __builtin_amdgcn_sched_barrier(0);
                if (ng > 2) { DSA_SCORE(a0, a1, 8) }
                if (ng > 3) { DSA_SCORE(b0, b1, 12) }
            }
#undef DSA_LOADK
#undef DSA_SCORE
        }
        __syncthreads();
        JREP(9)
#pragma unroll 1
        for (int qq = 0; qq < 2; ++qq) {
            const int q = c.wave * 2 + qq; const LAS unsigned* scq = sc + q * 2052; unsigned selw;
            if (ch < 8) selw = dsa_select<8>(scq, c.lane, ch); else if (ch < 16) selw = dsa_select<16>(scq, c.lane, ch);
            else if (ch < 24) selw = dsa_select<24>(scq, c.lane, ch); else selw = dsa_select<32>(scq, c.lane, ch);
            mask[(tq0 + q) * 64 + c.lane] = selw;
        }
        __syncthreads();
    }
}

__device__ __forceinline__ void gla_scan_job(const Ctx& c, const Args& a) {
    const us* ckv = (const us*)(a.ws + WS_CKV); const float* dec = (const float*)(a.ws + WS_DEC); us* st = (us*)(a.ws + WS_ST);
    for (int idx = c.bid * 512 + c.tid; idx < 4 * 4 * 256 * 32; idx += c.G * 512) {
        const int k4 = idx & 31, v = (idx >> 5) & 255, h = (idx >> 13) & 3, b = idx >> 15;
        f32x4 s = (f32x4){0.f, 0.f, 0.f, 0.f};
#pragma unroll 1
        for (int n0 = 0; n0 < 32; n0 += 16) {
            f32x4 d[16], kv[16];
#pragma unroll
            for (int u = 0; u < 16; ++u) { const size_t it = (size_t)((b * 32 + n0 + u) * 4 + h);
                d[u] = *(const f32x4*)(dec + it * 128 + 4 * k4); const u32x2 kw = __builtin_nontemporal_load((const u32x2*)(ckv + (it * 256 + v) * 128 + 4 * k4));
                kv[u] = (f32x4){__uint_as_float(kw.x << 16), __uint_as_float(kw.x & 0xFFFF0000u), __uint_as_float(kw.y << 16), __uint_as_float(kw.y & 0xFFFF0000u)}; }
#pragma unroll
            for (int u = 0; u < 16; ++u) { const size_t it = (size_t)((b * 32 + n0 + u) * 4 + h);
                s = s * d[u] + kv[u];
                u32x2 w; w.x = pg8::cvt_pk_bf16(s[0], s[1]); w.y = pg8::cvt_pk_bf16(s[2], s[3]);
                *(u32x2*)(st + (it * 256 + v) * 128 + 4 * k4) = w; }
        }
    }
}
__device__ __forceinline__ void dsa_attn_job(const Ctx& c, const Args& a) {
    const us* proj = (const us*)(a.ws + WS_PROJ); const us* dvt = (const us*)(a.ws + WS_DVT); const unsigned* mask = (const unsigned*)(a.ws + WS_MASK);
    const int* pos = (const int*)a.in[I_POS]; us* mix = (us*)(a.ws + WS_MIX);
    const int fr = c.lane & 15, g = c.lane >> 4;
    for (int wi = c.bid * 8 + c.wave; wi < 2048; wi += c.G * 8) {
        const int b = wi >> 9, h = (wi >> 7) & 3, qg = wi & 127;
        const size_t tq = (size_t)b * SEQ + qg * 16 + fr;
        const us* qr = proj + tq * DPROJ_P + C_DQ + h * 128;
        bf16x8 qf[4];
#pragma unroll
        for (int ks = 0; ks < 4; ++ks) qf[ks] = ld8(qr + 32 * ks + 8 * g);
        const float slope = exp2f(-2.0f * (float)(h + 1)), scale = 0.08838834764831845f;
        const int pq = pos[tq];
        u32x4 mw[4];
#pragma unroll
        for (int kb = 0; kb < 4; ++kb) mw[kb] = *(const u32x4*)(mask + tq * 64 + kb * 16 + 4 * g);
        f32x4 o[8];
#pragma unroll
        for (int db = 0; db < 8; ++db) o[db] = (f32x4){0.f, 0.f, 0.f, 0.f};
        float m = -1e30f, l = 0.f;
        const int ch = qg >> 2;
        for (int jt = 0; jt <= ch; ++jt) {
            f32x4 s[4];
#pragma unroll
            for (int kb = 0; kb < 4; ++kb) {
                const size_t kt = (size_t)b * SEQ + jt * 64 + kb * 16;
                const us* kr = proj + (kt + fr) * DPROJ_P + C_DK;
                f32x4 d = (f32x4){0.f, 0.f, 0.f, 0.f};
#pragma unroll
                for (int ks = 0; ks < 4; ++ks) d = mfma16(ld8(kr + 32 * ks + 8 * g), qf[ks], d);
                const int4 pk = *(const int4*)(pos + kt + 4 * g);
                const int pkk[4] = {pk.x, pk.y, pk.z, pk.w};
#pragma unroll
                for (int r = 0; r < 4; ++r) { const int dd = pq - pkk[r]; const float dist = (float)(dd < 0 ? -dd : dd);
                    const bool sel = (mw[kb][r] >> jt) & 1u;
                    s[kb][r] = sel ? d[r] * scale - slope * dist : -1e30f; }
            }
            float mx = -1e30f;
#pragma unroll
            for (int kb = 0; kb < 4; ++kb)
#pragma unroll
                for (int r = 0; r < 4; ++r) mx = fmaxf(mx, s[kb][r]);
            mx = fmaxf(mx, __shfl_xor(mx, 16)); mx = fmaxf(mx, __shfl_xor(mx, 32));
            const float mn = fmaxf(m, mx), alpha = __expf(m - mn); m = mn;
            float ps = 0.f; f32x4 p[4];
#pragma unroll
            for (int kb = 0; kb < 4; ++kb)
#pragma unroll
                for (int r = 0; r < 4; ++r) { const float pv = (s[kb][r] > -1e29f) ? __expf(s[kb][r] - mn) : 0.f; p[kb][r] = pv; ps += pv; }
            l = l * alpha + ps;
#pragma unroll
            for (int db = 0; db < 8; ++db) o[db] *= alpha;
            bf16x8 pf[2];
#pragma unroll
            for (int u = 0; u < 2; ++u) { const unsigned w0 = pk2(p[2 * u][0], p[2 * u][1]), w1 = pk2(p[2 * u][2], p[2 * u][3]), w2 = pk2(p[2 * u + 1][0], p[2 * u + 1][1]), w3 = pk2(p[2 * u + 1][2], p[2 * u + 1][3]);
                const u32x4 ww = (u32x4){w0, w1, w2, w3}; pf[u] = *(const bf16x8*)&ww; }
#pragma unroll
            for (int db = 0; db < 8; ++db) {
                const us* vr = dvt + ((size_t)b * 128 + db * 16 + fr) * SEQ + jt * 64 + 4 * g;
#pragma unroll
                for (int u = 0; u < 2; ++u) { const u32x2 lo = *(const u32x2*)(vr + 32 * u), hi = *(const u32x2*)(vr + 32 * u + 16);
                    const u32x4 vv = (u32x4){lo.x, lo.y, hi.x, hi.y};
                    o[db] = mfma16(*(const bf16x8*)&vv, pf[u], o[db]); }
            }
        }
        l += __shfl_xor(l, 16); l += __shfl_xor(l, 32);
        const float inv = 1.0f / l;
        us* op = mix + tq * D + 1536 + h * 128 + 4 * g;
#pragma unroll
        for (int db = 0; db < 8; ++db) { u32x2 w; w.x = pk2(o[db][0] * inv, o[db][1] * inv); w.y = pk2(o[db][2] * inv, o[db][3] * inv); *(u32x2*)(op + db * 16) = w; }
    }
}


template <bool DSA>
__device__ __forceinline__ void attn_tiled_job(const Ctx& c, const Args& a, int first_block, int nblocks) {
    constexpr int DQK = DSA ? 128 : 192, KBYTES = (DQK / 8) * 1024  , RSV = 144, POSOFF = KBYTES + 128 * RSV, BUF = POSOFF + 256, NKS = DQK / 32;
    const us* proj = (const us*)(a.ws + WS_PROJ);
    const us* Q = DSA ? proj : (const us*)(a.ws + WS_Q); const us* KN = (const us*)(a.ws + WS_KN); const us* KPE = (const us*)(a.ws + WS_KPE);
    const us* VT = DSA ? (const us*)(a.ws + WS_DVT) : (const us*)(a.ws + WS_VT);
    const unsigned* mask = (const unsigned*)(a.ws + WS_MASK); const int* pos = (const int*)a.in[I_POS]; us* mix = (us*)(a.ws + WS_MIX);
    const int fr = c.lane & 15, g = c.lane >> 4, w = c.wave;
    const int krow = (c.tid & 15) | (((c.tid >> 6) & 3) << 4), krc = ((c.tid >> 4) & 3) | (((c.tid >> 8) & 1) << 2);
    const int vb = c.bid - first_block; if (vb < 0 || vb >= nblocks) return;
    for (int pv = vb; pv < 128; pv += nblocks) {
        const int pi = (nblocks == 128 && (first_block & 7) == 0) ? (pv & 7) * 16 + (pv >> 3) : pv;
#pragma unroll 1
        for (int half = 0; half < 2; ++half) {
            int b, h, q0, ntiles, mych;
            if (DSA) { b = pi >> 5; const int jj = pi & 31, qb = half == 0 ? 63 - jj : jj; q0 = qb * 32; h = w & 3; mych = q0 >> 6; ntiles = mych + 1; }
            else { b = pi >> 5; h = (pi >> 3) & 3; const int jj = pi & 7, qb = half == 0 ? 15 - jj : jj; q0 = qb * 128; mych = (q0 + 16 * w) >> 6; ntiles = ((q0 + 127) >> 6) + 1; }
            const int qoff = DSA ? 16 * (w >> 2) : 16 * w;
            const size_t tq = (size_t)b * SEQ + q0 + qoff + fr;
            bf16x8 qf[NKS];
            { const us* qr = DSA ? proj + tq * DPROJ_P + C_DQ + h * 128 : Q + tq * 768 + h * 192;
#pragma unroll
              for (int ks = 0; ks < NKS; ++ks) qf[ks] = ld8(qr + 32 * ks + 8 * g); }
            const float scale = (DSA ? 0.08838834764831845f : 0.07216878364870322f) * 1.4426950408889634f;
            float slope = 0.f, pq = 0.f; u32x4 mw[4];
            if (DSA) { slope = exp2f(-2.0f * (float)(h + 1)) * 1.4426950408889634f; pq = (float)pos[tq];
#pragma unroll
                for (int kb = 0; kb < 4; ++kb) mw[kb] = *(const u32x4*)(mask + tq * 64 + kb * 16 + 4 * g); }
            f32x4 o[8];
#pragma unroll
            for (int db = 0; db < 8; ++db) o[db] = (f32x4){0.f, 0.f, 0.f, 0.f};
            float m = -1e30f, l = 0.f;
            u32x4 st[5]; f32x4 stp = (f32x4){0.f, 0.f, 0.f, 0.f};
            const size_t tokb = (size_t)b * SEQ;
#define ATT_LOAD(jt) do { const size_t k0 = tokb + (size_t)(jt) * 64; \
                _Pragma("unroll") for (int i = 0; i < 2; ++i) { const int c16 = krc + 8 * i; \
                    st[i] = DSA ? *(const u32x4*)(proj + (k0 + krow) * DPROJ_P + C_DK + c16 * 8) : *(const u32x4*)(KN + (k0 + krow) * 512 + h * 128 + c16 * 8); } \
                if (!DSA) { st[4] = *(const u32x4*)(KPE + (k0 + krow) * 64 + krc * 8); } \
                if (DSA && c.tid < 16) { const i32x4 pi_ = *(const i32x4*)(pos + k0 + 4 * c.tid); stp = (f32x4){(float)pi_[0], (float)pi_[1], (float)pi_[2], (float)pi_[3]}; } \
                _Pragma("unroll") for (int i = 0; i < 2; ++i) { const int id = c.tid + 512 * i, d = id >> 3, c16 = id & 7; \
                    st[2 + i] = DSA ? *(const u32x4*)(VT + ((size_t)b * 128 + d) * SEQ + (size_t)(jt) * 64 + c16 * 8) : *(const u32x4*)(VT + (size_t)(h * 128 + d) * NTOK + k0 + c16 * 8); } } while (0)
#define ATT_STORE(buf) do { LAS unsigned char* bp = c.lds + (buf) * BUF; \
                _Pragma("unroll") for (int i = 0; i < 2; ++i) *(LAS u32x4*)(bp + (krc + 8 * i) * 1024 + krow * 16) = st[i]; \
                if (!DSA) *(LAS u32x4*)(bp + (16 + krc) * 1024 + krow * 16) = st[4]; \
                if (DSA && c.tid < 16) *(LAS f32x4*)(bp + POSOFF + 16 * c.tid) = stp; \
                _Pragma("unroll") for (int i = 0; i < 2; ++i) { const int id = c.tid + 512 * i, d = id >> 3, c16 = id & 7; *(LAS u32x4*)(bp + KBYTES + d * RSV + c16 * 16) = st[2 + i]; } } while (0)
            ATT_LOAD(0); ATT_STORE(0);
            __syncthreads();
#pragma unroll 1
            for (int jt = 0; jt < ntiles; ++jt) {
                const bool more = jt + 1 < ntiles;
                if (more) ATT_LOAD(jt + 1);
                if (jt <= mych) {
                    const LAS unsigned char* bp = c.lds + (jt & 1) * BUF;
                    f32x4 s[4];
                    bf16x8 kfa[2][NKS], kfb[2][NKS]; f32x4 dq[4];
#define ATT_KRD(KF, KH) _Pragma("unroll") for (int k2 = 0; k2 < 2; ++k2) _Pragma("unroll") for (int ks = 0; ks < NKS; ++ks) \
                        KF[k2][ks] = *(const LAS bf16x8*)(bp + (4 * ks + g) * 1024 + ((2 * (KH) + k2) * 16 + fr) * 16)
#define ATT_QK(KF, KH) _Pragma("unroll") for (int k2 = 0; k2 < 2; ++k2) { f32x4 d = (f32x4){0.f, 0.f, 0.f, 0.f}; \
                        _Pragma("unroll") for (int ks = 0; ks < NKS; ++ks) d = mfma16(KF[k2][ks], qf[ks], d); dq[2 * (KH) + k2] = d; }
#define ATT_SC(KB) do { const f32x4 d = dq[KB]; \
                        if (DSA) { const f32x4 pk = *(const LAS f32x4*)(bp + POSOFF + ((KB) * 16 + 4 * g) * 4); \
                            _Pragma("unroll") for (int r = 0; r < 4; ++r) { const float sv = fmaf(-slope, fabsf(pq - pk[r]), d[r] * scale); \
                                const unsigned mk = (unsigned)__builtin_amdgcn_sbfe((int)mw[KB][r], (unsigned)jt, 1u);        \
                                s[KB][r] = __uint_as_float((__float_as_uint(sv) & mk) | (0xFF800000u & ~mk)); } \
                        } else s[KB] = d; } while (0)
                    ATT_KRD(kfa, 0);
                    __builtin_amdgcn_sched_barrier(0);
                    ATT_QK(kfa, 0)
                    ATT_KRD(kfb, 1);
                    __builtin_amdgcn_sched_barrier(0);
                    ATT_SC(0); ATT_SC(1);
                    ATT_QK(kfb, 1)
                    ATT_SC(2); ATT_SC(3);
#undef ATT_KRD
#undef ATT_QK
#undef ATT_SC
                    u32x2 vq[5][4];
#define ATT_VRD(db_) do { const LAS unsigned char* vr_ = bp + KBYTES + ((db_) * 16 + fr) * RSV + 8 * g; \
                        vq[(db_) % 5][0] = *(const volatile LAS u32x2*)(vr_); vq[(db_) % 5][1] = *(const volatile LAS u32x2*)(vr_ + 32); \
                        vq[(db_) % 5][2] = *(const volatile LAS u32x2*)(vr_ + 64); vq[(db_) % 5][3] = *(const volatile LAS u32x2*)(vr_ + 96); } while (0)
                    ATT_VRD(0); ATT_VRD(1); ATT_VRD(2); ATT_VRD(3);
                    float mx = -1e30f;
#pragma unroll
                    for (int kb = 0; kb < 4; ++kb)
#pragma unroll
                        for (int r = 0; r < 4; ++r) mx = fmaxf(mx, s[kb][r]);
                    mx = rows_max(mx);
                    if (!DSA) mx *= scale;
                    const float mn = fmaxf(m, mx), alpha = __builtin_amdgcn_exp2f(m - mn); m = mn;
                    float ps = 0.f; f32x4 p[4];
#pragma unroll
                    for (int kb = 0; kb < 4; ++kb)
#pragma unroll
                        for (int r = 0; r < 4; ++r) { const float pv = __builtin_amdgcn_exp2f(DSA ? s[kb][r] - mn : fmaf(s[kb][r], scale, -mn)); p[kb][r] = pv; ps += pv; }
                    if (__ballot(alpha != 1.0f) != 0ull) {
                        l *= alpha;
#pragma unroll
                        for (int db = 0; db < 8; ++db) o[db] *= alpha;
                    }
                    l += ps;
                    bf16x8 pf[2];
#pragma unroll
                    for (int u = 0; u < 2; ++u) { const u32x4 ww = (u32x4){pg8::cvt_pk_bf16_t(p[2 * u][0], p[2 * u][1]), pg8::cvt_pk_bf16_t(p[2 * u][2], p[2 * u][3]), pg8::cvt_pk_bf16_t(p[2 * u + 1][0], p[2 * u + 1][1]), pg8::cvt_pk_bf16_t(p[2 * u + 1][2], p[2 * u + 1][3])};
                        pf[u] = *(const bf16x8*)&ww; }
#pragma unroll
                    for (int db = 0; db < 8; ++db) {
                        if (db + 4 < 8) ATT_VRD(db + 4);
#pragma unroll
                        for (int u = 0; u < 2; ++u) { const u32x2 lo = vq[db % 5][2 * u], hi = vq[db % 5][2 * u + 1];
                            const u32x4 vv = (u32x4){lo.x, lo.y, hi.x, hi.y};
                            o[db] = mfma16(*(const bf16x8*)&vv, pf[u], o[db]); }
                    }
#undef ATT_VRD
                }
                if (more) ATT_STORE((jt + 1) & 1);
                __syncthreads();
            }
#undef ATT_LOAD
#undef ATT_STORE
            l = rows_sum(l);
            const float inv = 1.0f / l;
            unsigned char* op = (unsigned char*)mix + tq * D + (DSA ? 1536 : 0) + h * 128 + 4 * g;
#pragma unroll
            for (int db = 0; db < 8; ++db) *(unsigned*)(op + db * 16) = pk4_fp8(o[db][0] * inv, o[db][1] * inv, o[db][2] * inv, o[db][3] * inv);
        }
    }
}

__device__ __forceinline__ void mla_attn_job(const Ctx& c, const Args& a) {
    const us* Q = (const us*)(a.ws + WS_Q); const us* KN = (const us*)(a.ws + WS_KN); const us* KPE = (const us*)(a.ws + WS_KPE); const us* VT = (const us*)(a.ws + WS_VT);
    us* mix = (us*)(a.ws + WS_MIX);
    const int fr = c.lane & 15, g = c.lane >> 4;
    for (int wi = c.bid * 8 + c.wave; wi < 2048; wi += c.G * 8) {
        const int b = wi >> 9, h = (wi >> 7) & 3, qg = wi & 127;
        const size_t tq = (size_t)b * SEQ + qg * 16 + fr;
        const us* qr = Q + tq * 768 + h * 192;
        bf16x8 qf[6];
#pragma unroll
        for (int ks = 0; ks < 6; ++ks) qf[ks] = ld8(qr + 32 * ks + 8 * g);
        const float scale = 0.07216878364870322f;
        f32x4 o[8];
#pragma unroll
        for (int db = 0; db < 8; ++db) o[db] = (f32x4){0.f, 0.f, 0.f, 0.f};
        float m = -1e30f, l = 0.f;
        const int ch = qg >> 2;
        for (int jt = 0; jt <= ch; ++jt) {
            f32x4 s[4];
#pragma unroll
            for (int kb = 0; kb < 4; ++kb) {
                const size_t kt = (size_t)b * SEQ + jt * 64 + kb * 16 + fr;
                const us* kr = KN + kt * 512 + h * 128; const us* pr = KPE + kt * 64;
                f32x4 d = (f32x4){0.f, 0.f, 0.f, 0.f};
#pragma unroll
                for (int ks = 0; ks < 4; ++ks) d = mfma16(ld8(kr + 32 * ks + 8 * g), qf[ks], d);
#pragma unroll
                for (int ks = 0; ks < 2; ++ks) d = mfma16(ld8(pr + 32 * ks + 8 * g), qf[4 + ks], d);
                s[kb] = d * scale;
            }
            float mx = -1e30f;
#pragma unroll
            for (int kb = 0; kb < 4; ++kb)
#pragma unroll
                for (int r = 0; r < 4; ++r) mx = fmaxf(mx, s[kb][r]);
            mx = fmaxf(mx, __shfl_xor(mx, 16)); mx = fmaxf(mx, __shfl_xor(mx, 32));
            const float mn = fmaxf(m, mx), alpha = __expf(m - mn); m = mn;
            float ps = 0.f; f32x4 p[4];
#pragma unroll
            for (int kb = 0; kb < 4; ++kb)
#pragma unroll
                for (int r = 0; r < 4; ++r) { const float pv = __expf(s[kb][r] - mn); p[kb][r] = pv; ps += pv; }
            l = l * alpha + ps;
#pragma unroll
            for (int db = 0; db < 8; ++db) o[db] *= alpha;
            bf16x8 pf[2];
#pragma unroll
            for (int u = 0; u < 2; ++u) { const unsigned w0 = pk2(p[2 * u][0], p[2 * u][1]), w1 = pk2(p[2 * u][2], p[2 * u][3]), w2 = pk2(p[2 * u + 1][0], p[2 * u + 1][1]), w3 = pk2(p[2 * u + 1][2], p[2 * u + 1][3]);
                const u32x4 ww = (u32x4){w0, w1, w2, w3}; pf[u] = *(const bf16x8*)&ww; }
#pragma unroll
            for (int db = 0; db < 8; ++db) {
                const us* vr = VT + (size_t)(h * 128 + db * 16 + fr) * NTOK + (size_t)b * SEQ + jt * 64 + 4 * g;
#pragma unroll
                for (int u = 0; u < 2; ++u) { const u32x2 lo = *(const u32x2*)(vr + 32 * u), hi = *(const u32x2*)(vr + 32 * u + 16);
                    const u32x4 vv = (u32x4){lo.x, lo.y, hi.x, hi.y};
                    o[db] = mfma16(*(const bf16x8*)&vv, pf[u], o[db]); }
            }
        }
        l += __shfl_xor(l, 16); l += __shfl_xor(l, 32);
        const float inv = 1.0f / l;
        us* op = mix + tq * D + h * 128 + 4 * g;
#pragma unroll
        for (int db = 0; db < 8; ++db) { u32x2 w; w.x = pk2(o[db][0] * inv, o[db][1] * inv); w.y = pk2(o[db][2] * inv, o[db][3] * inv); *(u32x2*)(op + db * 16) = w; }
    }
}
__device__ __forceinline__ void gla_out_job(const Ctx& c, const Args& a, int l) {
    const us* proj = (const us*)(a.ws + WS_PROJ); const us* st = (const us*)(a.ws + WS_ST); us* mix = (us*)(a.ws + WS_MIX);
    const float* gn = a.in[I_GNG] + l * 256;
    const int fr = c.lane & 15, g = c.lane >> 4, w = c.wave, is = w >> 2, wq = w & 3;
    for (int ip = c.bid; ip < 256; ip += c.G) {
        const int item = 2 * ip + is; const int b = item >> 7, n = (item >> 2) & 31, h = item & 3;
        const us* sp = st + (size_t)item * 256 * 128;
        u32x4 sv[16];
#pragma unroll
        for (int u = 0; u < 16; ++u) { const int v = (c.tid & 15) | (wq << 4) | ((u & 3) << 6), ch = ((c.tid >> 4) & 3) | ((u >> 2) << 2); sv[u] = *(const u32x4*)(sp + (size_t)v * 128 + ch * 8); }
        const size_t tq = (size_t)b * SEQ + n * 64 + wq * 16 + fr;
        const us* qr = proj + tq * DPROJ_P + C_GQ + h * 128;
        bf16x8 qf[4];
#pragma unroll
        for (int ks = 0; ks < 4; ++ks) qf[ks] = ld8(qr + 32 * ks + 8 * g);
        const us* rr = proj + tq * DPROJ_P + C_GR + h * 256 + 64 * g; unsigned char* op = (unsigned char*)mix + tq * D + 512 + h * 256 + 64 * g;
        u32x4 rw[8];
#pragma unroll
        for (int j = 0; j < 8; ++j) rw[j] = *(const u32x4*)(rr + 8 * j);
        LAS unsigned char* lb = c.lds + is * 65536;
#pragma unroll
        for (int u = 0; u < 16; ++u) { const int v = (c.tid & 15) | (wq << 4) | ((u & 3) << 6), ch = ((c.tid >> 4) & 3) | ((u >> 2) << 2);
            const int p = (v & 3) + 4 * ((v >> 6) & 3) + 16 * ((v >> 2) & 15); *(LAS u32x4*)(lb + ch * 4096 + p * 16) = sv[u]; }
        __syncthreads();
        f32x4 acc[16]; float ss = 0.f;
#pragma unroll
        for (int vb = 0; vb < 16; ++vb) { f32x4 d = (f32x4){0.f, 0.f, 0.f, 0.f};
#pragma unroll
            for (int ks = 0; ks < 4; ++ks) d = mfma16(*(const LAS bf16x8*)(lb + (4 * ks + g) * 4096 + (vb * 16 + fr) * 16), qf[ks], d);
            d *= 0.08838834764831845f; acc[vb] = d; ss += d[0] * d[0] + d[1] * d[1] + d[2] * d[2] + d[3] * d[3]; }
        ss = rows_sum(ss);
        const float rstd = rsqrtf(ss * (1.0f / 256.0f) + EPS);
#pragma unroll
        for (int j = 0; j < 4; ++j) {
            unsigned ow[4];
#pragma unroll
            for (int q = 0; q < 4; ++q) { const int vb = 4 * j + q; const f32x4 gv = *(const f32x4*)(gn + 64 * g + 4 * vb);
                const u32x4 rq = rw[2 * j + (q >> 1)]; const unsigned r01 = (q & 1) ? rq.z : rq.x, r23 = (q & 1) ? rq.w : rq.y;
                const float r0 = __uint_as_float(r01 << 16), r1 = __uint_as_float(r01 & 0xFFFF0000u), r2 = __uint_as_float(r23 << 16), r3 = __uint_as_float(r23 & 0xFFFF0000u);
                ow[q] = pk4_fp8(acc[vb][0] * rstd * gv[0] * siluf(r0), acc[vb][1] * rstd * gv[1] * siluf(r1), acc[vb][2] * rstd * gv[2] * siluf(r2), acc[vb][3] * rstd * gv[3] * siluf(r3)); }
            *(u32x4*)(op + 16 * j) = (u32x4){ow[0], ow[1], ow[2], ow[3]};
            __builtin_amdgcn_sched_barrier(0);
        }
        __syncthreads();
    }
}

__device__ __forceinline__ void moe_assign_phase(const Ctx& c, const Args& a) {
    const int* rt = (const int*)(a.ws + WS_ROUTE); int* slot = (int*)(a.ws + WS_ROUTE) + 4 * NTOK; int* ctl = (int*)(a.ws + WS_MOECTL);
    int* s2t = (int*)(a.ws + WS_XG);
    LAS int* cnt = (LAS int*)c.lds;
    const int TPB = NTOK / 256;
    for (int vb = c.bid; vb < 256; vb += c.G) {
        if (c.tid < 32) cnt[c.tid] = 0;
        __syncthreads();
        const int t0 = vb * TPB;
        {
            int e0v[16], e1v[16];
#pragma unroll
            for (int u = 0; u < 16; ++u) { e0v[u] = rt[c.tid + 512 * u]; e1v[u] = rt[NTOK + c.tid + 512 * u]; }
            int la[8], lb[8];
#pragma unroll
            for (int e = 0; e < 8; ++e) { la[e] = 0; lb[e] = 0; }
#pragma unroll
            for (int u = 0; u < 16; ++u) { const bool bef = (c.tid + 512 * u) < t0;
#pragma unroll
                for (int e = 0; e < 8; ++e) { const int hit = (e0v[u] == e) + (e1v[u] == e); la[e] += hit; lb[e] += bef ? hit : 0; } }
#pragma unroll
            for (int e = 0; e < 8; ++e) { const int sa = wave_sum_dpp(la[e]), sb = wave_sum_dpp(lb[e]);
                if (c.lane == 0) { atomicAdd((int*)&cnt[e], sa); atomicAdd((int*)&cnt[8 + e], sb); } }
        }
        __syncthreads();
        if (c.tid < 32) {
            int start = 0, st[8], tl[8];
#pragma unroll
            for (int e = 0; e < 8; ++e) { const int tiles = (cnt[e] + 255) >> 8; st[e] = start; tl[e] = tiles; start += tiles * 256; }
            const int t = t0 + c.tid, e0 = rt[t], e1 = rt[NTOK + t];
            int s0 = 0, s1 = 0;
#pragma unroll
            for (int e = 0; e < 8; ++e) { const u64 m = __ballot(e0 == e || e1 == e); const int rank = __popcll(m & ((1ull << c.tid) - 1ull)), base = st[e] + cnt[8 + e];
                if (e0 == e) s0 = base + rank; if (e1 == e) s1 = base + rank; }
            cnt[32 + 2 * c.tid] = s0; cnt[33 + 2 * c.tid] = s1; slot[t] = s0; slot[NTOK + t] = s1;
            if (c.tid < 8) { cnt[16 + c.tid] = st[c.tid]; cnt[24 + c.tid] = tl[c.tid]; }
            if (vb == 0 && c.tid == 0) { int T = 0;
#pragma unroll
                for (int e = 0; e < 8; ++e) { for (int k = 0; k < tl[e]; ++k) ctl[16 + T + k] = e; T += tl[e]; ctl[128 + e] = cnt[e]; } ctl[0] = T; }
        }
        __syncthreads();
        if (c.tid < 64) s2t[cnt[32 + c.tid]] = t0 + (c.tid >> 1);
        { const int e = vb & 7, first = cnt[16 + e] + cnt[e], end = cnt[16 + e] + cnt[24 + e] * 256;
          for (int r = first + (vb >> 3) + 32 * c.tid; r < end; r += 32 * 512) s2t[r] = 0; }
        __syncthreads();
    }
}

__device__ __forceinline__ void final_phase(const Ctx& c, const Args& a) {
    const int* rt = (const int*)(a.ws + WS_ROUTE); const us* y = (const us*)(a.ws + WS_Y);
    const float* g2 = (const float*)(a.ws + WS_MOD) + (size_t)1 * 4 * 12288 + 10240; const float* fg = a.in[I_FNG];
    for (int rg = c.bid * 8 + c.wave; rg < NTOK / 4; rg += c.G * 8) {
        const int row0 = rg * 4, b = row0 >> 11;
        f32x4 xv[8], xn[8]; u32x2 ya[8], yb[8], yan[8], ybn[8];
        { const int s0 = rt[4 * NTOK + row0], s1 = rt[5 * NTOK + row0];
#pragma unroll
          for (int i = 0; i < 8; ++i) { const int col = (i * 64 + c.lane) * 4; xv[i] = ldx4<true>((const float*)(a.ws + WS_XB), (size_t)row0 * D + col); ya[i] = *(const u32x2*)(y + (size_t)s0 * D + col); yb[i] = *(const u32x2*)(y + (size_t)s1 * D + col); } }
#pragma unroll 1
        for (int k = 0; k < 4; ++k) {
            const int row = row0 + k; const float w0 = ((const float*)rt)[2 * NTOK + row], w1 = ((const float*)rt)[3 * NTOK + row];
            if (k < 3) { const int s0 = rt[4 * NTOK + row + 1], s1 = rt[5 * NTOK + row + 1];
#pragma unroll
                for (int i = 0; i < 8; ++i) { const int col = (i * 64 + c.lane) * 4; xn[i] = ldx4<true>((const float*)(a.ws + WS_XB), (size_t)(row + 1) * D + col); yan[i] = *(const u32x2*)(y + (size_t)s0 * D + col); ybn[i] = *(const u32x2*)(y + (size_t)s1 * D + col); } }
            f32x4 v[8]; float ss = 0.f;
#pragma unroll
            for (int i = 0; i < 8; ++i) {
                const f32x4 y0 = (f32x4){__uint_as_float(ya[i].x << 16), __uint_as_float(ya[i].x & 0xFFFF0000u), __uint_as_float(ya[i].y << 16), __uint_as_float(ya[i].y & 0xFFFF0000u)};
                const f32x4 y1 = (f32x4){__uint_as_float(yb[i].x << 16), __uint_as_float(yb[i].x & 0xFFFF0000u), __uint_as_float(yb[i].y << 16), __uint_as_float(yb[i].y & 0xFFFF0000u)};
                v[i] = xv[i] + *(const f32x4*)(g2 + (size_t)b * 12288 + (i * 64 + c.lane) * 4) * (y0 * w0 + y1 * w1);
                ss += v[i][0] * v[i][0] + v[i][1] * v[i][1] + v[i][2] * v[i][2] + v[i][3] * v[i][3]; }
            ss = wave_sum(ss);
            const float rstd = rsqrtf(ss * (1.0f / D) + EPS);
#pragma unroll
            for (int i = 0; i < 8; ++i) { const int col = (i * 64 + c.lane) * 4; *(f32x4*)(a.out + (size_t)row * D + col) = v[i] * rstd * *(const f32x4*)(fg + col); }
            if (k < 3) {
#pragma unroll
                for (int i = 0; i < 8; ++i) { xv[i] = xn[i]; ya[i] = yan[i]; yb[i] = ybn[i]; } }
        }
    }
}

constexpr int NPHASE = 24;
#ifndef PH_MASK
#define PH_MASK 0xFFFFFFu
#endif
#ifndef REP_MASK
#define REP_MASK 0x0u
#endif
#define IN(k) ((((PH_MASK) >> (k)) & 1u) && a.lo <= (k) && (k) < a.hi)
#define REP(k) _Pragma("unroll") for (int rep_ = 0; rep_ < 1 + (int)(((REP_MASK) >> (k)) & 1u); (++rep_ < 1 + (int)(((REP_MASK) >> (k)) & 1u)) ? xcd_barrier(bar) : (void)0)
#ifndef BAR_REPS
#define BAR_REPS 1
#endif
#define SEAM(k) do { if (a.lo <= (k) && (k) + 1 < a.hi) { _Pragma("unroll") for (int br_ = 0; br_ < BAR_REPS; ++br_) xcd_barrier(bar); } } while (0)

template <int l>
__device__ __forceinline__ void layer_phases(const Ctx& c, const Args& a, const XcdBarrier& bar) {
    constexpr int P = 1 + 11 * l;
    unsigned char* ws = a.ws;
    const float* modl = (const float*)(ws + WS_MOD) + (size_t)l * 4 * 12288;
    const float* xcur = (l == 0) ? a.in[I_X] : (const float*)(ws + WS_XB);
    const bool fuse_norms = (c.G == 256);
    if (!(l == 1 && fuse_norms) && !(l == 0 && IN(0) && IN(1))) {
        if (IN(P + 0)) REP(P + 0) norm_phase<false, 2, (l == 1)>(c, a, xcur, a.in[I_N1G] + l * D, modl, 0, 2048, (us*)(ws + WS_H), ws + WS_H8);
        SEAM(P + 0);
    }
    if (IN(P + 1)) REP(P + 1) {
        const bool deal3 = (c.G == 256);
        {
            pg8::Gemm g{D, D, D}; pg8::DenseSched S; S.init(ws + WS_H, (us*)(ws + WS_WIN) + (size_t)l * (DPROJ_P - NP8) * D, D, D, NTOK, DPROJ_P - NP8, c.G, c.bid);
            pg8::EpiBf16 E{(us*)(ws + WS_PROJ) + NP8, DPROJ_P, 0};
            pg8::gemm_phase<pg8::EpiBf16, pg8::DenseSched, true, true>(c.lds, g, S, E);
        }
        {
            pg8::Gemm g{D / 2, D / 2, D / 2}; pg8::DenseSched S;
            if (!deal3) S.init(ws + WS_H8, ws + WS_WIN8 + (size_t)l * NP8 * D, D / 2, D / 2, NTOK, NP8, c.G, c.bid);
            else if (c.bid < 96) S.init(ws + WS_H8, ws + WS_WIN8 + (size_t)l * NP8 * D, D / 2, D / 2, NTOK, NP8, 96, c.bid, 0, 96);
            else S.init(ws + WS_H8, ws + WS_WIN8 + (size_t)l * NP8 * D, D / 2, D / 2, NTOK, NP8, 160, c.bid - 96, 96);
            pg8::EpiBf16 E{(us*)(ws + WS_PROJ), DPROJ_P, 0};
            pg8::gemm_phase<pg8::EpiBf16, pg8::DenseSched, true, true, true>(c.lds, g, S, E);
        }
    }
    SEAM(P + 1);
    if (IN(P + 2)) REP(P + 2) {
#ifndef SKIP_J0
        JREP(0) { rowstats_job(c, a); dvt_job(c, a); }
#endif
#ifndef SKIP_J1
        JREP(1) gla_a_job(c, a, l);
#endif
#ifndef SKIP_J2
        JREP(2) dsa_index_job(c, a);
#endif
    }
    SEAM(P + 2);
    if (IN(P + 3)) REP(P + 3) {
        const float* rs = (const float*)(ws + WS_RSTD);
#ifndef SKIP_J3
        {
            pg8::Gemm g{DPROJ_P, 512, 512}; pg8::DenseSched S; S.init((const us*)(ws + WS_PROJ) + C_CQ, (us*)(ws + WS_WUQ) + (size_t)l * 768 * 512, DPROJ_P, 512, NTOK, 768, c.G, c.bid);
            pg8::EpiQRope E{(us*)(ws + WS_Q), rs, (const float*)(ws + WS_CS)};
            pg8::gemm_phase<pg8::EpiQRope, pg8::DenseSched, false, true>(c.lds, g, S, E);
        }
#endif
#ifndef SKIP_J4
#ifndef SKIP_J4A
        {
            pg8::Gemm g{DPROJ_P, 256, 256}; pg8::DenseSched S; S.init((const us*)(ws + WS_PROJ) + C_CKV, (us*)(ws + WS_WUKV) + (size_t)l * 1024 * 256, DPROJ_P, 256, NTOK, 512, c.G, (c.bid + c.G - 96 % c.G) % c.G);
            pg8::EpiScaleRow E{(us*)(ws + WS_KN), 512, rs + NTOK};
            pg8::gemm_phase<pg8::EpiScaleRow, pg8::DenseSched, false, true>(c.lds, g, S, E);
        }
#endif
#ifndef SKIP_J4B
        {
            pg8::Gemm g{256, DPROJ_P, 256}; pg8::DenseSched S; S.init((us*)(ws + WS_WUKV) + (size_t)l * 1024 * 256 + (size_t)512 * 256, (const us*)(ws + WS_PROJ) + C_CKV, 256, DPROJ_P, 512, NTOK, c.G, (c.bid + c.G - 160 % c.G) % c.G);
            pg8::EpiScaleCol E{(us*)(ws + WS_VT), NTOK, rs + NTOK};
            pg8::gemm_phase<pg8::EpiScaleCol, pg8::DenseSched, false, true>(c.lds, g, S, E);
        }
#endif
#endif
#ifndef SKIP_J5
        JREP(5) gla_scan_job(c, a);
#endif
    }
    SEAM(P + 3);
    if (IN(P + 4)) REP(P + 4) {
        const int hg = c.G >> 1;
        JREP(6) { if (c.bid < hg) attn_tiled_job<false>(c, a, 0, hg); else attn_tiled_job<true>(c, a, hg, c.G - hg); }
        JEXTRA(10) { if (c.bid < hg) attn_tiled_job<false>(c, a, 0, hg); }
        JEXTRA(11) { if (c.bid >= hg) attn_tiled_job<true>(c, a, hg, c.G - hg); }
        JREP(7) gla_out_job(c, a, l);
    }
    SEAM(P + 4);
    if (IN(P + 5)) REP((l == 0) ? P + 5 : 31) {
        pg8::Gemm g{D / 2, D / 2, D / 2}; pg8::DenseSched S; S.init(ws + WS_MIX, ws + WS_WOUT + (size_t)l * D * D, D / 2, D / 2, NTOK, D, c.G, c.bid);
        if (l == 0 && fuse_norms) {
            pg8::EpiResidNorm<true, false> E{a.in[I_X], (us*)(ws + WS_XB), modl + 4096, 12288, a.in[I_N2G], modl, 6144, 8192, ws + WS_H, nullptr,
                                             (unsigned*)(ws + WS_NSLOT), (unsigned*)(ws + WS_NCNT), (unsigned*)(ws + WS_BAR) + XB_TMO};
            pg8::gemm_phase<pg8::EpiResidNorm<true, false>, pg8::DenseSched, false, true, true>(c.lds, g, S, E);
        } else {
            pg8::EpiResid<(l == 0)> E{a.in[I_X], (us*)(ws + WS_XB), modl + 4096, 12288};
            pg8::gemm_phase<pg8::EpiResid<(l == 0)>, pg8::DenseSched, false, true, true>(c.lds, g, S, E);
        }
    }
    SEAM(P + 5);
    if (!(l == 0 && fuse_norms)) {
        if (IN(P + 6)) REP(P + 6) norm_phase<(l == 1), 1, true>(c, a, (const float*)(ws + WS_XB), a.in[I_N2G] + l * D, modl, 6144, 8192, (us*)(ws + WS_H));
        SEAM(P + 6);
    }
    if constexpr (l == 0) {
        if (IN(P + 8)) REP(P + 8) {
            pg8::Gemm g{D / 2, D / 2, D / 2}; pg8::DenseSched S; S.init(ws + WS_H, ws + WS_WGU, D / 2, D / 2, NTOK, 2 * DFF, c.G, c.bid);
            pg8::EpiSwiglu<true> E{(us*)(ws + WS_ACT), DFF, nullptr, 0ull, 0u};
            pg8::gemm_phase<pg8::EpiSwiglu<true>, pg8::DenseSched, true, true, true>(c.lds, g, S, E);
            if (c.G == 256) cvt_range(c, a, CVT_TILES - CVT_DEFER - CVT_DEFER_UP, CVT_TILES - CVT_DEFER, 128, 128);
        }
        SEAM(P + 8);
        if (IN(P + 9)) {
            pg8::Gemm g{DFF / 2, DFF / 2, DFF / 2}; pg8::DenseSched S; S.init(ws + WS_ACT, ws + WS_WD, DFF / 2, DFF / 2, NTOK, D, c.G, c.bid);
#ifdef XDOWN_EXP
            { pg8::EpiResid<false> Ed{nullptr, (us*)(ws + WS_XG), modl + 10240, 12288};
              pg8::gemm_phase<pg8::EpiResid<false>, pg8::DenseSched, false, true, true>(c.lds, g, S, Ed); xcd_barrier(bar); }
#endif
            if (fuse_norms) {
                pg8::EpiResidNorm<false, true> E{nullptr, (us*)(ws + WS_XB), modl + 10240, 12288, a.in[I_N1G] + D, modl + 4 * 12288, 0, 2048, ws + WS_H8, (us*)(ws + WS_H),
                                                 (unsigned*)(ws + WS_NSLOT) + (size_t)NTOK * 8, (unsigned*)(ws + WS_NCNT) + 32 * 64, (unsigned*)(ws + WS_BAR) + XB_TMO};
                pg8::gemm_phase<pg8::EpiResidNorm<false, true>, pg8::DenseSched, false, true, true>(c.lds, g, S, E);
            } else {
                pg8::EpiResid<false> E{nullptr, (us*)(ws + WS_XB), modl + 10240, 12288};
                pg8::gemm_phase<pg8::EpiResid<false>, pg8::DenseSched, false, true, true>(c.lds, g, S, E);
            }
        }
        SEAM(P + 9);
    } else {
        if (IN(P + 7)) REP(P + 7) moe_assign_phase(c, a);
        SEAM(P + 7);
        unsigned* mcnt = (unsigned*)(ws + WS_NCNT); const int* mctl = (const int*)(ws + WS_MOECTL);
        constexpr int NNU = 2 * DFFE / pg8::BM, NND = D / pg8::BM, ROT = 20;
        const int nT = mctl[0], nup = nT * NNU, ndn = nT * NND;
        const int sh = ((nup % c.G + 7) / 8 * 8) % c.G, c0 = (c.bid - sh + c.G) % c.G, rem = ndn % c.G;
        const int nearly = (sh > 0 && rem <= c.G - sh) ? rem : 0;
        volatile LAS unsigned* emw = (volatile LAS unsigned*)(c.lds + LDS_CTL + 32);
        if (c.tid < 3) emw[c.tid] = 0u;
        __syncthreads();
        if (c.tid < nearly) { int pm, pn; pg8::remap_moe(c.tid, ndn, nT, NND, 1, ROT, pm, pn); atomicOr((unsigned*)(emw + (pm >> 5)), 1u << (pm & 31)); }
        __syncthreads();
        const unsigned long long emlo = (unsigned long long)emw[0] | ((unsigned long long)emw[1] << 32); const unsigned emhi = emw[2];
        if (IN(P + 8)) {
            pg8::Gemm g{D / 2, D / 2, D / 2}; pg8::MoeSched S; S.init(ws + WS_H, ws + WS_MGU, D / 2, D / 2, (size_t)2 * DFFE * D, mctl, 2 * DFFE, c.G, c.bid, 2, 0); S.s2t = (const int*)(ws + WS_XG);
            pg8::EpiSwiglu<true> E{(us*)(ws + WS_ACT), DFFE, mcnt, emlo, emhi};
            pg8::gemm_phase<pg8::EpiSwiglu<true>, pg8::MoeSched, true, true, true, true>(c.lds, g, S, E);
        }
        const bool pre = c0 < nearly;
        if (IN(P + 9) && pre) {
            pg8::Gemm g{DFFE / 2, DFFE / 2, DFFE / 2}; pg8::MoeSched S; S.init(ws + WS_ACT, ws + WS_MD, DFFE / 2, DFFE / 2, (size_t)D * DFFE, mctl, D, c.G, c0, 1, ROT, 0, nearly);
            { int pm0, pn0; pg8::remap_moe(c0, ndn, nT, NND, 1, ROT, pm0, pn0); pg8::moe_wait(mcnt, pm0, (unsigned)NNU * 8u, (unsigned*)(ws + WS_BAR) + XB_TMO); __syncthreads(); }
            pg8::EpiBf16 E{(us*)(ws + WS_Y), D, 0};
            pg8::gemm_phase<pg8::EpiBf16, pg8::MoeSched, true, true, true>(c.lds, g, S, E);
        }
        SEAM(P + 8);
        if (IN(P + 9)) {
            pg8::Gemm g{DFFE / 2, DFFE / 2, DFFE / 2}; pg8::MoeSched S; S.init(ws + WS_ACT, ws + WS_MD, DFFE / 2, DFFE / 2, (size_t)D * DFFE, mctl, D, c.G, c0, 1, ROT, pre ? 1 : 0);
            pg8::EpiBf16 E{(us*)(ws + WS_Y), D, 0};
            pg8::gemm_phase<pg8::EpiBf16, pg8::MoeSched, true, true, true>(c.lds, g, S, E);
        }
        SEAM(P + 9);
    }
}

__global__ void __launch_bounds__(512, 2) mega(Args a) {
    extern __shared__ __attribute__((aligned(16))) unsigned char lds_raw[];
    Ctx c; c.lds = (LAS unsigned char*)lds_raw; c.tid = threadIdx.x; c.lane = c.tid & 63; c.wave = __builtin_amdgcn_readfirstlane(c.tid >> 6); c.G = gridDim.x; c.bid = blockIdx.x;
    volatile LAS unsigned* stw = (volatile LAS unsigned*)(c.lds + LDS_CTL);
    if (c.tid < 4) stw[c.tid] = 0u;
    __syncthreads();
    XcdBarrier bar; bar.bar = (unsigned*)(a.ws + WS_BAR); bar.x = 0; bar.st = stw;
    if (a.use_bar) bar = xcd_barrier_post((unsigned*)(a.ws + WS_BAR), stw);
#ifndef PROLOGUE_REPS
#define PROLOGUE_REPS 1
#endif
    if (IN(0)) {
#pragma unroll 1
        for (int pr_ = 0; pr_ < PROLOGUE_REPS; ++pr_) { prologue_phase(c, a); if (pr_ + 1 < PROLOGUE_REPS) xcd_barrier(bar); }
        if (IN(1)) {
            pg8::cnt_wait((unsigned*)(a.ws + WS_NCNT) + 48, 96u, (unsigned*)(a.ws + WS_BAR) + XB_TMO);
            __syncthreads();
            norm_phase<false, 2, false>(c, a, a.in[I_X], a.in[I_N1G], (const float*)(a.ws + WS_MOD), 0, 2048, (us*)(a.ws + WS_H), a.ws + WS_H8);
        }
    }
    SEAM(0);
    layer_phases<0>(c, a, bar);
    layer_phases<1>(c, a, bar);
    if (IN(23)) final_phase(c, a);
}
#undef IN
#undef SEAM

extern "C" void kernel_launch(void* const* d_in, const int* in_sizes, int n_in, void* d_out, int out_size, void* d_ws, size_t ws_size, hipStream_t stream) {
    static int grid = 0;
    if (grid == 0) {
        if (n_in != 25 || out_size != NTOK * D || ws_size < WS_END) { fprintf(stderr, "kernel_launch: unexpected shapes (n_in %d out %d ws %zu need %zu)\n", n_in, out_size, ws_size, (size_t)WS_END); grid = -1; return; }
        int dev = 0, cus = 0, per_cu = 0;
        if (hipGetDevice(&dev) != hipSuccess || hipDeviceGetAttribute(&cus, hipDeviceAttributeMultiprocessorCount, dev) != hipSuccess) { grid = -1; return; }
        if (hipFuncSetAttribute((const void*)mega, hipFuncAttributeMaxDynamicSharedMemorySize, LDS_BYTES) != hipSuccess) { fprintf(stderr, "kernel_launch: hipFuncSetAttribute failed\n"); grid = -1; return; }
        if (hipOccupancyMaxActiveBlocksPerMultiprocessor(&per_cu, (const void*)mega, 512, LDS_BYTES) != hipSuccess || per_cu < 1) { fprintf(stderr, "kernel_launch: occupancy query says %d\n", per_cu); }
        (void)hipGetLastError();
        grid = cus;
    }
    if (grid < 0) return;
    (void)hipMemsetAsync((char*)d_ws + WS_BAR, 0, 32768, stream);
    Args a{};
    for (int i = 0; i < 25; ++i) a.in[i] = (const float*)d_in[i];
    a.out = (float*)d_out; a.ws = (unsigned char*)d_ws; a.pad_ = 0;
#if MK_LAUNCH_PER_PHASE
    a.use_bar = 0;
    for (int p = 0; p < NPHASE; ++p) {
        if (p == 8 || p == 11 || p == 22) continue;
        a.lo = p; a.hi = p + 1;
        hipLaunchKernelGGL(mega, dim3(grid), dim3(512), LDS_BYTES, stream, a);
    }
#else
    a.use_bar = 1; a.lo = 0; a.hi = NPHASE;
    hipLaunchKernelGGL(mega, dim3(grid), dim3(512), LDS_BYTES, stream, a);
#endif
}
```
